# Optimizing an MI355X kernel written in HIP

```python
import jax, jax.numpy as jnp
from jax import lax
import numpy as np

D_MODEL = 1024
BATCH = 8
SEQ = 8192
DEPTH = 1

CHUNK = 64
Q_BLOCK = 128
D_FF = 2816
HG_HEADS = 8
HG_HEAD_K = 128
HG_HEAD_V = 128
HG_WIDTH = HG_HEADS * HG_HEAD_K
HG_VWIDTH = HG_HEADS * HG_HEAD_V
MLA_HEADS = 8
MLA_NOPE = 128
MLA_ROPE = 64
MLA_V = 128
MLA_QK = MLA_NOPE + MLA_ROPE
Q_LORA = 384
KV_LORA = 256
ROPE_THETA = 10000.0
EPS = 1e-6
IN_SPLITS = (HG_WIDTH, HG_WIDTH, HG_VWIDTH, HG_VWIDTH, Q_LORA, KV_LORA, MLA_ROPE)
IN_COLS = 2 * HG_WIDTH + 2 * HG_VWIDTH + Q_LORA + KV_LORA + MLA_ROPE

kernel_name = 'hybrid_hgrn2_mla_macaron'


def _rms_norm(x, gain):
    xf = x.astype(jnp.float32)
    y = xf * lax.rsqrt(jnp.mean(xf * xf, axis=-1, keepdims=True) + EPS)
    return (y * gain.astype(jnp.float32)).astype(x.dtype)


def _swiglu(x, w_in, w_out):
    gate, up = jnp.split(x @ w_in, 2, axis=-1)
    return (jax.nn.silu(gate) * up) @ w_out


def _rotate(x, cos, sin):
    half = x.shape[-1] // 2
    x1, x2 = x[..., :half], x[..., half:]
    return jnp.concatenate([x1 * cos - x2 * sin, x2 * cos + x1 * sin], axis=-1)


def _to_chunks(t):
    b, s, h, d = t.shape
    return t.reshape(b, s // CHUNK, CHUNK, h, d).transpose(1, 0, 3, 2, 4)


def _from_chunks(t):
    n, b, h, c, d = t.shape
    return t.transpose(1, 0, 3, 2, 4).reshape(b, n * c, h, d)


def _hgrn2_chunk_step(state, inputs):
    q, k, v, log_f = inputs
    cum = jnp.cumsum(log_f, axis=2)
    o_inter = jnp.einsum('bhtk,bhkv->bhtv', q * jnp.exp(cum), state)
    causal = jnp.tril(jnp.ones((CHUNK, CHUNK), dtype=bool))[:, :, None]
    rel = cum[:, :, :, None, :] - cum[:, :, None, :, :]
    decay = jnp.exp(jnp.where(causal, rel, -jnp.inf))
    scores = jnp.einsum('bhtk,bhtsk,bhsk->bhts', q, decay, k)
    o_intra = jnp.einsum('bhts,bhsv->bhtv', scores, v)
    last = cum[:, :, -1, :]
    new_state = jnp.exp(last)[..., None] * state + jnp.einsum(
        'bhsk,bhsv->bhkv', k * jnp.exp(last[:, :, None, :] - cum), v)
    return new_state, o_intra + o_inter


def _hgrn2(q_raw, f_raw, i_raw, g_raw, lower_bound, out_gain):
    b, s, _ = q_raw.shape
    f32 = jnp.float32
    q = jax.nn.silu(q_raw.astype(f32)).reshape(b, s, HG_HEADS, HG_HEAD_K)
    z = f_raw.astype(f32).reshape(b, s, HG_HEADS, HG_HEAD_K)
    lb = lower_bound.astype(f32).reshape(HG_HEADS, HG_HEAD_K)
    log_f = jnp.logaddexp(jnp.log(lb), jnp.log1p(-lb) + jax.nn.log_sigmoid(z))
    k = -jnp.expm1(log_f)
    v = i_raw.astype(f32).reshape(b, s, HG_HEADS, HG_HEAD_V)
    state0 = jnp.zeros((b, HG_HEADS, HG_HEAD_K, HG_HEAD_V), f32)
    _, o = lax.scan(_hgrn2_chunk_step, state0,
                    (_to_chunks(q), _to_chunks(k), _to_chunks(v), _to_chunks(log_f)))
    o = _rms_norm(_from_chunks(o), out_gain)
    o = o * jax.nn.silu(g_raw.astype(f32)).reshape(b, s, HG_HEADS, HG_HEAD_V)
    return o.reshape(b, s, HG_VWIDTH).astype(q_raw.dtype)


def _mla(c_q, c_kv, k_pe, positions, q_lora_gain, w_q_up, kv_lora_gain, w_kv_up,
         q_head_gain, k_head_gain):
    b, s, _ = c_q.shape
    q = (_rms_norm(c_q, q_lora_gain) @ w_q_up).reshape(b, s, MLA_HEADS, MLA_QK)
    kv = (_rms_norm(c_kv, kv_lora_gain) @ w_kv_up).reshape(b, s, MLA_HEADS, MLA_NOPE + MLA_V)
    k_nope, v = kv[..., :MLA_NOPE], kv[..., MLA_NOPE:]
    k = jnp.concatenate(
        [k_nope, jnp.broadcast_to(k_pe[:, :, None, :], (b, s, MLA_HEADS, MLA_ROPE))], axis=-1)
    q = _rms_norm(q, q_head_gain)
    k = _rms_norm(k, k_head_gain)
    inv_freq = ROPE_THETA ** (-jnp.arange(0, MLA_ROPE, 2, dtype=jnp.float32) / MLA_ROPE)
    ang = positions.astype(jnp.float32)[:, :, None, None] * inv_freq
    cos = jnp.cos(ang).astype(q.dtype)
    sin = jnp.sin(ang).astype(q.dtype)
    q = jnp.concatenate([q[..., :MLA_NOPE], _rotate(q[..., MLA_NOPE:], cos, sin)], axis=-1)
    k = jnp.concatenate([k[..., :MLA_NOPE], _rotate(k[..., MLA_NOPE:], cos, sin)], axis=-1)
    n_blocks = s // Q_BLOCK
    q_blocks = q.reshape(b, n_blocks, Q_BLOCK, MLA_HEADS, MLA_QK).transpose(1, 0, 2, 3, 4)
    key_chunk = jnp.arange(s) // CHUNK
    scale = MLA_QK ** -0.5

    def attend(args):
        q_blk, blk = args
        q_chunk = (blk * Q_BLOCK + jnp.arange(Q_BLOCK)) // CHUNK
        allowed = key_chunk[None, :] <= q_chunk[:, None]
        logits = jnp.einsum('bqhd,bkhd->bhqk', q_blk, k).astype(jnp.float32) * scale
        logits = jnp.where(allowed, logits, -jnp.inf)
        probs = jax.nn.softmax(logits, axis=-1).astype(v.dtype)
        return jnp.einsum('bhqk,bkhd->bqhd', probs, v)

    o = lax.map(attend, (q_blocks, jnp.arange(n_blocks)))
    return o.transpose(1, 0, 2, 3, 4).reshape(b, s, MLA_HEADS * MLA_V)


def setup_inputs(seed: int = 0) -> dict:
    key = jax.random.key(seed)
    ks = jax.random.split(key, 24)
    f32 = jnp.float32
    L = DEPTH

    def w(k, shape, fan_in):
        return jax.random.normal(k, shape, f32) * (fan_in ** -0.5)

    def gain(k, shape):
        return 1.0 + 0.05 * jax.random.normal(k, shape, f32)

    x = jax.random.normal(ks[0], (BATCH, SEQ, D_MODEL), f32)
    offsets = jax.random.randint(ks[1], (BATCH, 1), 0, 64, dtype=jnp.int32) * CHUNK
    positions = (offsets + jnp.arange(SEQ, dtype=jnp.int32)[None, :]).astype(jnp.int32)
    return {
        'x': x,
        'positions': positions,
        'ffn1_norm': gain(ks[2], (L, D_MODEL)),
        'ffn1_w_in': w(ks[3], (L, D_MODEL, 2 * D_FF), D_MODEL),
        'ffn1_w_out': w(ks[4], (L, D_FF, D_MODEL), D_FF),
        'mix_norm': gain(ks[5], (L, D_MODEL)),
        'w_in': w(ks[6], (L, D_MODEL, IN_COLS), D_MODEL),
        'hg_lb_table': 0.5 * jax.random.normal(ks[7], (L + 1, HG_WIDTH), f32),
        'hg_out_norm': gain(ks[8], (L, HG_HEAD_V)),
        'w_hg_branch': w(ks[9], (L, HG_VWIDTH, D_MODEL), HG_VWIDTH),
        'mla_q_lora_norm': gain(ks[10], (L, Q_LORA)),
        'w_q_up': w(ks[11], (L, Q_LORA, MLA_HEADS * MLA_QK), Q_LORA),
        'mla_kv_lora_norm': gain(ks[12], (L, KV_LORA)),
        'w_kv_up': w(ks[13], (L, KV_LORA, MLA_HEADS * (MLA_NOPE + MLA_V)), KV_LORA),
        'q_head_norm': gain(ks[14], (L, MLA_QK)),
        'k_head_norm': gain(ks[15], (L, MLA_QK)),
        'w_mla_branch': w(ks[16], (L, MLA_HEADS * MLA_V, D_MODEL), MLA_HEADS * MLA_V),
        'w_merge': w(ks[17], (L, D_MODEL, 2 * D_MODEL), D_MODEL),
        'b_merge': 0.02 * jax.random.normal(ks[18], (L, 2 * D_MODEL), f32),
        'w_out': w(ks[19], (L, D_MODEL, D_MODEL), D_MODEL),
        'ffn2_norm': gain(ks[20], (L, D_MODEL)),
        'ffn2_w_in': w(ks[21], (L, D_MODEL, 2 * D_FF), D_MODEL),
        'ffn2_w_out': w(ks[22], (L, D_FF, D_MODEL), D_FF),
        'final_norm': gain(ks[23], (L, D_MODEL)),
    }


def reference(x, positions, ffn1_norm, ffn1_w_in, ffn1_w_out, mix_norm, w_in, hg_lb_table,
              hg_out_norm, w_hg_branch, mla_q_lora_norm, w_q_up, mla_kv_lora_norm, w_kv_up,
              q_head_norm, k_head_norm, w_mla_branch, w_merge, b_merge, w_out,
              ffn2_norm, ffn2_w_in, ffn2_w_out, final_norm):
    lower_bounds = jnp.cumsum(jax.nn.softmax(hg_lb_table.astype(jnp.float32), axis=0), axis=0)
    split_at = np.cumsum(IN_SPLITS)[:-1].tolist()
    h = x
    for l in range(DEPTH):
        h = h + 0.5 * _swiglu(_rms_norm(h, ffn1_norm[l]), ffn1_w_in[l], ffn1_w_out[l])
        u = _rms_norm(h, mix_norm[l])
        hg_q, hg_f, hg_i, hg_g, c_q, c_kv, k_pe = jnp.split(u @ w_in[l], split_at, axis=-1)
        y_hg = _hgrn2(hg_q, hg_f, hg_i, hg_g, lower_bounds[l], hg_out_norm[l]) @ w_hg_branch[l]
        y_mla = _mla(c_q, c_kv, k_pe, positions, mla_q_lora_norm[l], w_q_up[l],
                     mla_kv_lora_norm[l], w_kv_up[l], q_head_norm[l], k_head_norm[l]) @ w_mla_branch[l]
        g_hg, g_mla = jnp.split(jax.nn.sigmoid(u @ w_merge[l] + b_merge[l]), 2, axis=-1)
        h = h + (g_hg * y_hg + g_mla * y_mla) @ w_out[l]
        h = h + 0.5 * _swiglu(_rms_norm(h, ffn2_norm[l]), ffn2_w_in[l], ffn2_w_out[l])
        h = _rms_norm(h, final_norm[l])
    return h
```

```cpp
#include <hip/hip_runtime.h>
#include <hip/hip_cooperative_groups.h>
#include <cstdio>
#include <cstdint>
namespace cg = cooperative_groups;
namespace pg8 {
#define PG8_LAS __attribute__((address_space(3)))
typedef unsigned short bf16_t;
typedef short bf16x8 __attribute__((ext_vector_type(8)));
typedef float f32x4 __attribute__((ext_vector_type(4)));
typedef unsigned u32x4 __attribute__((ext_vector_type(4)));
constexpr int BM = 256, BK = 64, HALF = 128, HTB = HALF * BK * 2  , STAGE_BYTES = 8 * HTB, NXCD = 8, WGM = 8;

__host__ __device__ __forceinline__ int lds_byte(int r, int c) { const int st = (r >> 4) * 2 + (c >> 5), rr = r & 15, cc = c & 31, ob = rr * 64 + cc * 2; return st * 1024 + (ob ^ (((ob >> 9) & 1) << 5)); }
__host__ __device__ __forceinline__ void stage_rc(int b, int& R, int& C) { const int st = b / 1024, sb = b % 1024, swz = sb ^ (((sb >> 9) & 1) << 5); R = (st >> 1) * 16 + swz / 64; C = (st & 1) * 32 + (swz % 64) / 2; }
__host__ __device__ __forceinline__ int perm32(int rho) { const int n = rho >> 4, i = rho & 15; return 8 * (i >> 2) + 4 * n + (i & 3); }

struct Unit { int pm, pn; };
struct Gemm { const bf16_t* A; const bf16_t* Bt; int M, N, K, lda, ldb; };

struct StaticOrder {
    int nM, nN, nwg, G, c;
    __host__ __device__ void init(int M, int N, int G_, int c_) { nM = M / BM; nN = N / BM; nwg = nM * nN; G = G_; c = c_; }
    __host__ __device__ bool next(int i, Unit& u) const {
        const long L = (long)i * G + c; if (L >= nwg) return false;
        int wgid = (int)L; { const int q = nwg / NXCD, r = nwg % NXCD, xcd = wgid % NXCD, off = wgid / NXCD; wgid = (xcd < r ? xcd * (q + 1) : r * (q + 1) + (xcd - r) * q) + off; }
        const int nig = WGM * nN, gid = wgid / nig, fm = gid * WGM, gsz = (nM - fm) < WGM ? (nM - fm) : WGM;
        u.pm = fm + ((wgid % nig) % gsz); u.pn = (wgid % nig) / gsz; return true;
    }
    __device__ __forceinline__ void a_ready(const Unit&) const {}
    __device__ __forceinline__ void done(const Unit&) const {}
};

__device__ __forceinline__ unsigned cvt_pk_bf16(float lo, float hi) { unsigned r; asm volatile("v_cvt_pk_bf16_f32 %0, %1, %2" : "=v"(r) : "v"(lo), "v"(hi)); return r; }
typedef float f32x2 __attribute__((ext_vector_type(2)));
template <class Epi, class Sched, bool ALIGN_EPI = false, bool SP2 = false>
__device__ __forceinline__ void gemm_phase(PG8_LAS unsigned char* lds, const Gemm g, const Sched& S, const Epi& E) {
    int tid_l = threadIdx.x; asm volatile("" : "+v"(tid_l));
    const int tid = tid_l, wid = __builtin_amdgcn_readfirstlane(tid >> 6), lane = tid & 63, wr = wid >> 2, wc = wid & 3, fr = lane & 15, fq = lane >> 4;
    int Kopaque = g.K; asm volatile("" : "+s"(Kopaque));
    const int K = Kopaque, nt = K / BK;
    unsigned voffA[2], voffB[2];
#pragma unroll
    for (int i = 0; i < 2; ++i) { int R, C; stage_rc(tid * 16 + i * 8192, R, C); const int Rb = Epi::PERM ? ((R & ~31) + perm32(R & 31)) : R;
        voffA[i] = (unsigned)(R * g.lda + C) * 2u; voffB[i] = (unsigned)(Rb * g.ldb + C) * 2u; }
    const size_t kstep = (size_t)(BK * 2);
    const size_t hstepA = (size_t)HALF * g.lda * 2, hstepB = (size_t)HALF * g.ldb * 2;
    const size_t tstepA = 2 * hstepA, tstepB = 2 * hstepB;
    const unsigned ldsw = (unsigned)wid * 1024u;
    const int aoff = lds_byte(wr * 64 + fr, fq * 8), boff = lds_byte(wc * 32 + fr, fq * 8);
#define PG8_SA(b, h) (((b) * 2 + (h)) * HTB)
#define PG8_SB(b, h) ((4 + (b) * 2 + (h)) * HTB)
#define PG8_STAGE(bufoff, gbase, voff) do { _Pragma("unroll") for (int _i = 0; _i < 2; ++_i) \
        __builtin_amdgcn_global_load_lds((const unsigned*)((const char*)(gbase) + (voff)[_i]), (PG8_LAS unsigned*)(lds + (bufoff) + ldsw + _i * 8192), 16, 0, 0); } while (0)
#define PG8_LDA(dst, b, h) do { _Pragma("unroll") for (int m = 0; m < 4; ++m) _Pragma("unroll") for (int k = 0; k < 2; ++k) dst[m][k] = *(const PG8_LAS bf16x8*)(lds + PG8_SA(b, h) + aoff + m * 2048 + k * 1024); } while (0)
#define PG8_LDB(dst, b, h) do { _Pragma("unroll") for (int n = 0; n < 2; ++n) _Pragma("unroll") for (int k = 0; k < 2; ++k) dst[n][k] = *(const PG8_LAS bf16x8*)(lds + PG8_SB(b, h) + boff + n * 2048 + k * 1024); } while (0)
#define PG8_MMA(ai, bj, At, Bt) do { __builtin_amdgcn_s_setprio(1); _Pragma("unroll") for (int m = 0; m < 4; ++m) _Pragma("unroll") for (int n = 0; n < 2; ++n) _Pragma("unroll") for (int k = 0; k < 2; ++k) \
        acc[ai][bj][m][n] = __builtin_amdgcn_mfma_f32_16x16x32_bf16(Bt[n][k], At[m][k], acc[ai][bj][m][n], 0, 0, 0); __builtin_amdgcn_s_setprio(0); } while (0)
#define PG8_WAIT_V(n) asm volatile("s_waitcnt vmcnt(" #n ")" ::: "memory")
#define PG8_WAIT_L(n) asm volatile("s_waitcnt lgkmcnt(" #n ")" ::: "memory")
#define PG8_BAR __builtin_amdgcn_s_barrier()
#define PG8_SCHED __builtin_amdgcn_sched_barrier(0)
    Unit cur, nxt; int ui = 0;
    if (!S.next(0, cur)) return;
    f32x4 acc[2][2][4][2];
#pragma unroll
    for (int a = 0; a < 2; ++a)
#pragma unroll
        for (int b = 0; b < 2; ++b)
#pragma unroll
            for (int m = 0; m < 4; ++m)
#pragma unroll
                for (int n = 0; n < 2; ++n) acc[a][b][m][n] = (f32x4){0.f, 0.f, 0.f, 0.f};
    bf16x8 At[4][2], B0[2][2], B1[2][2];
    const char* cA = (const char*)g.A + (size_t)cur.pm * tstepA; const char* cB = (const char*)g.Bt + (size_t)cur.pn * tstepB;
    S.a_ready(cur);
    if constexpr (SP2) {
        PG8_STAGE(PG8_SB(0, 0), cB, voffB); PG8_STAGE(PG8_SB(0, 1), cB + hstepB, voffB); PG8_STAGE(PG8_SA(0, 0), cA, voffA); PG8_STAGE(PG8_SA(0, 1), cA + hstepA, voffA);
        if (wr == 1) PG8_BAR;
        PG8_WAIT_V(2); PG8_BAR;
        PG8_STAGE(PG8_SB(1, 0), cB + kstep, voffB); PG8_STAGE(PG8_SA(1, 0), cA + kstep, voffA); PG8_STAGE(PG8_SB(1, 1), cB + hstepB + kstep, voffB);
        PG8_WAIT_V(6); PG8_BAR;
    } else {
        PG8_STAGE(PG8_SB(0, 0), cB, voffB); PG8_STAGE(PG8_SA(0, 0), cA, voffA); PG8_STAGE(PG8_SB(0, 1), cB + hstepB, voffB); PG8_STAGE(PG8_SA(0, 1), cA + hstepA, voffA);
        if (wr == 1) PG8_BAR;
        PG8_WAIT_V(4); PG8_BAR;
        PG8_STAGE(PG8_SB(1, 0), cB + kstep, voffB); PG8_STAGE(PG8_SA(1, 0), cA + kstep, voffA); PG8_STAGE(PG8_SB(1, 1), cB + hstepB + kstep, voffB);
        PG8_WAIT_V(6); PG8_BAR;
    }
    for (;;) {
        const bool has_next = S.next(ui + 1, nxt);
        const char* nA = has_next ? (const char*)g.A + (size_t)nxt.pm * tstepA : cA; const char* nB = has_next ? (const char*)g.Bt + (size_t)nxt.pn * tstepB : cB;
        for (int t = 0; t < nt; t += 2) {
            if constexpr (Epi::MID) { if (t == (nt >> 1)) E.mid(acc, cur, wr, wc, fr, fq); }
            const bool last = (t == nt - 2);
            const char* a1 = cA + (size_t)(t + 1) * kstep;
            const char* a2 = last ? nA : cA + (size_t)(t + 2) * kstep; const char* b2 = last ? nB : cB + (size_t)(t + 2) * kstep;
            const char* a3 = a2 + kstep; const char* b3 = b2 + kstep;
            if (last && has_next) S.a_ready(nxt);
            if constexpr (SP2) {
            PG8_LDB(B0, 0, 0); PG8_LDB(B1, 0, 1); PG8_SCHED; PG8_LDA(At, 0, 0); PG8_STAGE(PG8_SA(1, 1), a1 + hstepA, voffA);
            PG8_WAIT_V(8); PG8_WAIT_L(0); PG8_BAR; PG8_MMA(0, 0, At, B0); PG8_MMA(0, 1, At, B1); PG8_BAR; PG8_SCHED;
            PG8_LDA(At, 0, 1); PG8_STAGE(PG8_SB(0, 0), b2, voffB); PG8_STAGE(PG8_SB(0, 1), b2 + hstepB, voffB); PG8_STAGE(PG8_SA(0, 0), a2, voffA);
            PG8_WAIT_V(8); PG8_WAIT_L(0); PG8_BAR; PG8_MMA(1, 0, At, B0); PG8_MMA(1, 1, At, B1); PG8_BAR; PG8_SCHED;
            PG8_LDB(B0, 1, 0); PG8_LDB(B1, 1, 1); PG8_SCHED; PG8_LDA(At, 1, 0); PG8_STAGE(PG8_SA(0, 1), a2 + hstepA, voffA);
            PG8_WAIT_V(8); PG8_WAIT_L(0); PG8_BAR; PG8_MMA(0, 0, At, B0); PG8_MMA(0, 1, At, B1); PG8_BAR; PG8_SCHED;
            PG8_LDA(At, 1, 1); PG8_STAGE(PG8_SB(1, 0), b3, voffB); PG8_STAGE(PG8_SB(1, 1), b3 + hstepB, voffB); PG8_STAGE(PG8_SA(1, 0), a3, voffA);
            PG8_WAIT_V(8); PG8_WAIT_L(0); PG8_BAR; PG8_MMA(1, 0, At, B0); PG8_MMA(1, 1, At, B1); PG8_BAR; PG8_SCHED;
            } else {
            PG8_LDB(B0, 0, 0); PG8_SCHED; PG8_LDA(At, 0, 0); PG8_STAGE(PG8_SA(1, 1), a1 + hstepA, voffA);
            PG8_WAIT_L(8); PG8_BAR; PG8_WAIT_L(0); PG8_MMA(0, 0, At, B0); PG8_BAR; PG8_SCHED;
            PG8_LDB(B1, 0, 1); PG8_STAGE(PG8_SB(0, 0), b2, voffB);
            PG8_BAR; PG8_WAIT_L(0); PG8_MMA(0, 1, At, B1); PG8_BAR;
            PG8_LDA(At, 0, 1); PG8_STAGE(PG8_SA(0, 0), a2, voffA);
            PG8_BAR; PG8_WAIT_L(0); PG8_MMA(1, 0, At, B0); PG8_BAR; PG8_SCHED;
            PG8_STAGE(PG8_SB(0, 1), b2 + hstepB, voffB);
            PG8_WAIT_V(6); PG8_BAR; PG8_MMA(1, 1, At, B1); PG8_BAR;
            PG8_LDB(B0, 1, 0); PG8_SCHED; PG8_LDA(At, 1, 0); PG8_STAGE(PG8_SA(0, 1), a2 + hstepA, voffA);
            PG8_WAIT_L(8); PG8_BAR; PG8_WAIT_L(0); PG8_MMA(0, 0, At, B0); PG8_BAR; PG8_SCHED;
            PG8_LDB(B1, 1, 1); PG8_STAGE(PG8_SB(1, 0), b3, voffB);
            PG8_BAR; PG8_WAIT_L(0); PG8_MMA(0, 1, At, B1); PG8_BAR;
            PG8_LDA(At, 1, 1); PG8_STAGE(PG8_SA(1, 0), a3, voffA);
            PG8_BAR; PG8_WAIT_L(0); PG8_MMA(1, 0, At, B0); PG8_BAR; PG8_SCHED;
            PG8_STAGE(PG8_SB(1, 1), b3 + hstepB, voffB);
            PG8_WAIT_V(6); PG8_BAR; PG8_MMA(1, 1, At, B1); PG8_BAR;
            }
        }
        if constexpr (ALIGN_EPI) { if (wr == 0) PG8_BAR; }
        if constexpr (!Epi::AFTER_DRAIN) { E(acc, cur, wr, wc, fr, fq); S.done(cur); }
        if (!has_next) break;
#pragma unroll
        for (int a = 0; a < 2; ++a)
#pragma unroll
            for (int b = 0; b < 2; ++b)
#pragma unroll
                for (int m = 0; m < 4; ++m)
#pragma unroll
                    for (int n = 0; n < 2; ++n) acc[a][b][m][n] = (f32x4){0.f, 0.f, 0.f, 0.f};
        cur = nxt; cA = nA; cB = nB; ++ui;
        if constexpr (ALIGN_EPI) { if (wr == 1) PG8_BAR; }
    }
    PG8_WAIT_V(0);
    if constexpr (!ALIGN_EPI) { if (wr == 0) PG8_BAR; }
    PG8_BAR;
    if constexpr (Epi::AFTER_DRAIN) { E.fused(acc, cur, wr, wc, fr, fq, lds, wid, lane); S.done(cur); }
#undef PG8_SA
#undef PG8_SB
#undef PG8_STAGE
#undef PG8_LDA
#undef PG8_LDB
#undef PG8_MMA
#undef PG8_WAIT_V
#undef PG8_WAIT_L
#undef PG8_BAR
#undef PG8_SCHED
}
}

constexpr int BATCH = 8, SEQ = 8192, DM = 1024, T = BATCH * SEQ, DFF = 2816;
constexpr int NIN = 4864;
constexpr float EPS = 1e-6f;
constexpr float QSCALE = 0.07216878364870322f * 1.4426950408889634f;

#define LAS __attribute__((address_space(3)))
typedef unsigned short bf16_t;
typedef short bf16x8 __attribute__((ext_vector_type(8)));
typedef short s16x4 __attribute__((ext_vector_type(4)));
typedef float f32x4 __attribute__((ext_vector_type(4)));
typedef float f32x16 __attribute__((ext_vector_type(16)));
typedef unsigned u32x4 __attribute__((ext_vector_type(4)));
typedef unsigned u32x2 __attribute__((ext_vector_type(2)));

__device__ __forceinline__ float bf2f(bf16_t v) { return __uint_as_float(((unsigned)v) << 16); }
__device__ __forceinline__ unsigned f2bf(float f) { unsigned u = __float_as_uint(f); return (u + 0x7fffu + ((u >> 16) & 1u)) >> 16; }
__device__ __forceinline__ unsigned pk2(float lo, float hi) { return pg8::cvt_pk_bf16(lo, hi); }
__device__ __forceinline__ float fast_rcp(float x) { return __builtin_amdgcn_rcpf(x); }
__device__ __forceinline__ float silu_f(float x) { return x * fast_rcp(1.0f + __expf(-x)); }
__device__ __forceinline__ float sigmoid_f(float x) { return fast_rcp(1.0f + __expf(-x)); }
__device__ __forceinline__ float wave_sum(float v) {
#pragma unroll
    for (int o = 1; o < 64; o <<= 1) v += __shfl_xor(v, o);
    return v;
}

#define LDS_BARRIER() do { asm volatile("s_waitcnt lgkmcnt(0)" ::: "memory"); __builtin_amdgcn_s_barrier(); asm volatile("" ::: "memory"); } while (0)
constexpr size_t MiB = 1u << 20;
constexpr size_t WS_SSQ_MIX = 0, WS_SSQ_CQ = 256 * 1024, WS_SSQ_CKV = 512 * 1024, WS_SSQ2 = 768 * 1024;
constexpr size_t WS_W1IN = 2 * MiB;
constexpr size_t WS_W1OUT = WS_W1IN + (size_t)5632 * 1024 * 2;
constexpr size_t WS_WIN = WS_W1OUT + (size_t)1024 * 2816 * 2;
constexpr size_t WS_WMG = WS_WIN + (size_t)NIN * 1024 * 2;
constexpr size_t WS_WQ = WS_WMG + (size_t)2048 * 1024 * 2;
constexpr size_t WS_WKV = WS_WQ + (size_t)1536 * 384 * 2;
constexpr size_t WS_WBR = WS_WKV + (size_t)2048 * 256 * 2;
constexpr size_t WS_WOUT = WS_WBR + (size_t)1024 * 2048 * 2;
constexpr size_t WS_W2IN = WS_WOUT + (size_t)1024 * 1024 * 2;
constexpr size_t WS_W2OUT = WS_W2IN + (size_t)5632 * 1024 * 2;
constexpr size_t WS_WEND = WS_W2OUT + (size_t)1024 * 2816 * 2;
static_assert(WS_WEND <= 60 * MiB, "weights fit");
constexpr size_t WS_SSQO = 60 * MiB;
constexpr size_t WS_R3 = 64 * MiB;
constexpr size_t WS_P = WS_R3, WS_ER = WS_R3 + 32 * MiB, WS_DR = WS_R3 + 40 * MiB;
constexpr size_t WS_IG = 192 * MiB;
constexpr size_t WS_QF = 448 * MiB;
constexpr size_t WS_CQG = 704 * MiB;
constexpr size_t WS_CKVG = 752 * MiB;
constexpr size_t WS_KPE = 784 * MiB;
constexpr size_t WS_KF = 792 * MiB;
constexpr size_t WS_HID = 192 * MiB;
constexpr size_t WS_NEED = 984 * MiB;

constexpr int LDS_BYTES = 147456;

struct Params {
    const float* in[24];
    float* out;
    unsigned char* ws;
};

typedef const f32x4 (&AccRef)[2][2][4][2];

struct EpiSwiglu {
    static constexpr bool PERM = true, AFTER_DRAIN = false, MID = false;
    bf16_t* O; const float* ssq;
    __device__ __forceinline__ void mid(f32x4 (&)[2][2][4][2], const pg8::Unit&, int, int, int, int) const {}
    __device__ __forceinline__ void operator()(AccRef acc, const pg8::Unit& u, int wr, int wc, int fr, int fq) const {
        const int col = u.pn * 128 + wc * 32 + 8 * fq;
#pragma unroll
        for (int ai = 0; ai < 2; ++ai)
#pragma unroll
            for (int m = 0; m < 4; ++m) {
                const int row = u.pm * 256 + ai * 128 + wr * 64 + m * 16 + fr;
                const float s = ssq ? rsqrtf(ssq[row] * (1.0f / 1024.0f) + EPS) : 1.0f;
                float h[8];
#pragma unroll
                for (int n = 0; n < 2; ++n)
#pragma unroll
                    for (int j = 0; j < 4; ++j) { const float g = acc[ai][0][m][n][j] * s, up = acc[ai][1][m][n][j] * s; h[n * 4 + j] = silu_f(g) * up; }
                u32x4 w; w.x = pk2(h[0], h[1]); w.y = pk2(h[2], h[3]); w.z = pk2(h[4], h[5]); w.w = pk2(h[6], h[7]);
                *(u32x4*)(O + (size_t)row * DFF + col) = w;
            }
    }
};

template <class TB, class TO, int COEF2> struct EpiRes {
    static constexpr bool PERM = true, AFTER_DRAIN = false, MID = false;
    static constexpr bool BASE_BF16 = sizeof(TB) == 2, OUT_BF16 = sizeof(TO) == 2;
    static constexpr float coef = 0.5f * COEF2;
    const TB* base; TO* out; bf16_t* og; const float* gain; float* ssq;
    __device__ __forceinline__ void mid(f32x4 (&)[2][2][4][2], const pg8::Unit&, int, int, int, int) const {}
    __device__ __forceinline__ void operator()(AccRef acc, const pg8::Unit& u, int wr, int wc, int fr, int fq) const {
        const int col0 = u.pn * 256 + wc * 32 + 8 * fq;
        f32x4 gv[2][2];
#pragma unroll
        for (int bj = 0; bj < 2; ++bj)
#pragma unroll
            for (int n = 0; n < 2; ++n) gv[bj][n] = og ? *(const f32x4*)(gain + col0 + bj * 128 + 4 * n) : (f32x4){0.f, 0.f, 0.f, 0.f};
#pragma unroll
        for (int ai = 0; ai < 2; ++ai)
#pragma unroll
            for (int m = 0; m < 4; ++m) {
                const int row = u.pm * 256 + ai * 128 + wr * 64 + m * 16 + fr;
                float sq = 0.f;
#pragma unroll
                for (int bj = 0; bj < 2; ++bj) {
                    const size_t off = (size_t)row * DM + col0 + bj * 128;
                    f32x4 b0, b1;
                    if (BASE_BF16) { const u32x4 bb = *(const u32x4*)((const bf16_t*)base + off);
                        b0 = (f32x4){__uint_as_float(bb.x << 16), __uint_as_float(bb.x & 0xffff0000u), __uint_as_float(bb.y << 16), __uint_as_float(bb.y & 0xffff0000u)};
                        b1 = (f32x4){__uint_as_float(bb.z << 16), __uint_as_float(bb.z & 0xffff0000u), __uint_as_float(bb.w << 16), __uint_as_float(bb.w & 0xffff0000u)}; }
                    else { b0 = *(const f32x4*)((const float*)base + off); b1 = *(const f32x4*)((const float*)base + off + 4); }
                    const f32x4 o0 = b0 + acc[ai][bj][m][0] * coef, o1 = b1 + acc[ai][bj][m][1] * coef;
                    if (OUT_BF16) { u32x4 w; w.x = pk2(o0[0], o0[1]); w.y = pk2(o0[2], o0[3]); w.z = pk2(o1[0], o1[1]); w.w = pk2(o1[2], o1[3]); *(u32x4*)((bf16_t*)out + off) = w; }
                    else { *(f32x4*)((float*)out + off) = o0; *(f32x4*)((float*)out + off + 4) = o1; }
                    sq += (o0[0] * o0[0] + o0[1] * o0[1]) + (o0[2] * o0[2] + o0[3] * o0[3]) + (o1[0] * o1[0] + o1[1] * o1[1]) + (o1[2] * o1[2] + o1[3] * o1[3]);
                    if (og) { const f32x4 y0 = o0 * gv[bj][0], y1 = o1 * gv[bj][1];
                        u32x4 w; w.x = pk2(y0[0], y0[1]); w.y = pk2(y0[2], y0[3]); w.z = pk2(y1[0], y1[1]); w.w = pk2(y1[2], y1[3]);
                        *(u32x4*)(og + off) = w; }
                }
                if (ssq) { sq += __shfl_xor(sq, 16); sq += __shfl_xor(sq, 32); if (fq == 0) atomicAdd(ssq + row, sq); }
            }
    }
};

struct EpiIn {
    static constexpr bool PERM = true, AFTER_DRAIN = false, MID = false;
    bf16_t *QF, *IG, *cqg, *ckvg, *kpe; const float* ssq_mix; float *ssq_cq, *ssq_ckv; const float *gq, *gkv;
    __device__ __forceinline__ void mid(f32x4 (&)[2][2][4][2], const pg8::Unit&, int, int, int, int) const {}
    __device__ __forceinline__ void operator()(AccRef acc, const pg8::Unit& u, int wr, int wc, int fr, int fq) const {
        float sr[2][4];
#pragma unroll
        for (int ai = 0; ai < 2; ++ai)
#pragma unroll
            for (int m = 0; m < 4; ++m) sr[ai][m] = rsqrtf(ssq_mix[u.pm * 256 + ai * 128 + wr * 64 + m * 16 + fr] * (1.0f / 1024.0f) + EPS);
#pragma unroll
        for (int bj = 0; bj < 2; ++bj) {
            const int c0 = u.pn * 256 + bj * 128, cc = c0 + wc * 32 + 8 * fq;
            bf16_t* dst; int ld; const float* gain = nullptr; float* ssq = nullptr;
            if (c0 < 2048) { dst = QF + cc; ld = 2048; }
            else if (c0 < 4096) { dst = IG + (cc - 2048); ld = 2048; }
            else if (c0 < 4480) { dst = cqg + (cc - 4096); ld = 384; gain = gq + (cc - 4096); ssq = ssq_cq; }
            else if (c0 < 4736) { dst = ckvg + (cc - 4480); ld = 256; gain = gkv + (cc - 4480); ssq = ssq_ckv; }
            else { if (wc >= 2) continue; dst = kpe + (cc - 4736); ld = 64; }
            f32x4 g0 = (f32x4){1.f, 1.f, 1.f, 1.f}, g1 = g0;
            if (gain) { g0 = *(const f32x4*)gain; g1 = *(const f32x4*)(gain + 4); }
#pragma unroll
            for (int ai = 0; ai < 2; ++ai)
#pragma unroll
                for (int m = 0; m < 4; ++m) {
                    const int row = u.pm * 256 + ai * 128 + wr * 64 + m * 16 + fr;
                    const f32x4 v0 = acc[ai][bj][m][0] * sr[ai][m], v1 = acc[ai][bj][m][1] * sr[ai][m];
                    if (ssq) { float sq = (v0[0] * v0[0] + v0[1] * v0[1]) + (v0[2] * v0[2] + v0[3] * v0[3]) + (v1[0] * v1[0] + v1[1] * v1[1]) + (v1[2] * v1[2] + v1[3] * v1[3]);
                        sq += __shfl_xor(sq, 16); sq += __shfl_xor(sq, 32); if (fq == 0) atomicAdd(ssq + row, sq); }
                    const f32x4 y0 = v0 * g0, y1 = v1 * g1;
                    u32x4 w; w.x = pk2(y0[0], y0[1]); w.y = pk2(y0[2], y0[3]); w.z = pk2(y1[0], y1[1]); w.w = pk2(y1[2], y1[3]);
                    *(u32x4*)(dst + (size_t)row * ld) = w;
                }
        }
    }
};

template <int ldc, int hs> struct EpiPlain {
    static constexpr bool PERM = true, AFTER_DRAIN = false, MID = false;
    bf16_t* O;
    __device__ __forceinline__ void mid(f32x4 (&)[2][2][4][2], const pg8::Unit&, int, int, int, int) const {}
    __device__ __forceinline__ void operator()(AccRef acc, const pg8::Unit& u, int wr, int wc, int fr, int fq) const {
#pragma unroll
        for (int ai = 0; ai < 2; ++ai)
#pragma unroll
            for (int m = 0; m < 4; ++m) {
                const int row = u.pm * 256 + ai * 128 + wr * 64 + m * 16 + fr;
#pragma unroll
                for (int bj = 0; bj < 2; ++bj) {
                    const int col = (u.pn * 2 + bj) * hs + wc * 32 + 8 * fq;
                    const f32x4 y0 = acc[ai][bj][m][0], y1 = acc[ai][bj][m][1];
                    u32x4 w; w.x = pk2(y0[0], y0[1]); w.y = pk2(y0[2], y0[3]); w.z = pk2(y1[0], y1[1]); w.w = pk2(y1[2], y1[3]);
                    *(u32x4*)(O + (size_t)row * ldc + col) = w;
                }
            }
    }
};

struct EpiGate {
    static constexpr bool PERM = true, AFTER_DRAIN = false, MID = false;
    bf16_t* G; const float* ssq_mix; const float* bias;
    __device__ __forceinline__ void mid(f32x4 (&)[2][2][4][2], const pg8::Unit&, int, int, int, int) const {}
    __device__ __forceinline__ void operator()(AccRef acc, const pg8::Unit& u, int wr, int wc, int fr, int fq) const {
        const int col0 = u.pn * 256 + wc * 32 + 8 * fq;
        f32x4 bv[2][2];
#pragma unroll
        for (int bj = 0; bj < 2; ++bj)
#pragma unroll
            for (int n = 0; n < 2; ++n) bv[bj][n] = *(const f32x4*)(bias + col0 + bj * 128 + 4 * n);
#pragma unroll
        for (int ai = 0; ai < 2; ++ai)
#pragma unroll
            for (int m = 0; m < 4; ++m) {
                const int row = u.pm * 256 + ai * 128 + wr * 64 + m * 16 + fr;
                const float s = rsqrtf(ssq_mix[row] * (1.0f / 1024.0f) + EPS);
#pragma unroll
                for (int bj = 0; bj < 2; ++bj) {
                    const f32x4 a0 = acc[ai][bj][m][0] * s + bv[bj][0], a1 = acc[ai][bj][m][1] * s + bv[bj][1];
                    u32x4 w; w.x = pk2(sigmoid_f(a0[0]), sigmoid_f(a0[1])); w.y = pk2(sigmoid_f(a0[2]), sigmoid_f(a0[3]));
                    w.z = pk2(sigmoid_f(a1[0]), sigmoid_f(a1[1])); w.w = pk2(sigmoid_f(a1[2]), sigmoid_f(a1[3]));
                    *(u32x4*)(G + (size_t)row * 2048 + col0 + bj * 128) = w;
                }
            }
    }
};

template <bool SECOND> struct EpiBranch {
    static constexpr bool PERM = true, AFTER_DRAIN = false, MID = false;
    const bf16_t* G; int gcol0; bf16_t* tmp; bf16_t* O;
    __device__ __forceinline__ void mid(f32x4 (&)[2][2][4][2], const pg8::Unit&, int, int, int, int) const {}
    __device__ __forceinline__ void operator()(AccRef acc, const pg8::Unit& u, int wr, int wc, int fr, int fq) const {
        const int col0 = u.pn * 256 + wc * 32 + 8 * fq;
#pragma unroll
        for (int ai = 0; ai < 2; ++ai)
#pragma unroll
            for (int m = 0; m < 4; ++m) {
                const int row = u.pm * 256 + ai * 128 + wr * 64 + m * 16 + fr;
#pragma unroll
                for (int bj = 0; bj < 2; ++bj) {
                    const u32x4 gh = *(const u32x4*)(G + (size_t)row * 2048 + gcol0 + col0 + bj * 128);
                    u32x4 tv = (u32x4){0u, 0u, 0u, 0u};
                    if (SECOND) tv = *(const u32x4*)(tmp + (size_t)row * DM + col0 + bj * 128);
                    float y[8];
#pragma unroll
                    for (int q = 0; q < 4; ++q) {
                        const float h0 = __uint_as_float(gh[q] << 16), h1 = __uint_as_float(gh[q] & 0xffff0000u);
                        const float t0 = __uint_as_float(tv[q] << 16), t1 = __uint_as_float(tv[q] & 0xffff0000u);
                        const int n = q >> 1, j = (q & 1) * 2;
                        y[2 * q] = acc[ai][bj][m][n][j] * h0 + t0; y[2 * q + 1] = acc[ai][bj][m][n][j + 1] * h1 + t1;
                    }
                    u32x4 w; w.x = pk2(y[0], y[1]); w.y = pk2(y[2], y[3]); w.z = pk2(y[4], y[5]); w.w = pk2(y[6], y[7]);
                    *(u32x4*)((SECOND ? O : tmp) + (size_t)row * DM + col0 + bj * 128) = w;
                }
            }
    }
};

template <class Epi, bool ALIGN = true>
__device__ __forceinline__ void run_gemm(LAS unsigned char* lds, const bf16_t* A, const bf16_t* Bt, int M, int N, int K, const Epi& E, int G, int c, int lda = 0, int ldb = 0) {
    pg8::Gemm g{A, Bt, M, N, K, lda ? lda : K, ldb ? ldb : K}; pg8::StaticOrder S; S.init(M, N, G, c);
    pg8::gemm_phase<Epi, pg8::StaticOrder, ALIGN, true>(lds, g, S, E);
}

typedef __attribute__((address_space(4))) const unsigned char* karg_ptr_t;
__device__ __forceinline__ const float* karg_in(int i) { karg_ptr_t kp = (karg_ptr_t)__builtin_amdgcn_kernarg_segment_ptr(); asm volatile("" : "+s"(kp)); return *(const float* __attribute__((address_space(4))) const*)(kp + 8 * i); }
__device__ __forceinline__ float* karg_out() { karg_ptr_t kp = (karg_ptr_t)__builtin_amdgcn_kernarg_segment_ptr(); asm volatile("" : "+s"(kp)); return *(float* __attribute__((address_space(4))) const*)(kp + 8 * 24); }
__device__ __forceinline__ unsigned char* karg_ws() { karg_ptr_t kp = (karg_ptr_t)__builtin_amdgcn_kernarg_segment_ptr(); asm volatile("" : "+s"(kp)); return *(unsigned char* __attribute__((address_space(4))) const*)(kp + 8 * 25); }
__device__ __forceinline__ int tr_map(int mode, int n) {
    if (mode == 0) return n;
    if (mode == 1) { if (n < DFF) return 256 * (n >> 7) + (n & 127); const int n2 = n - DFF; return 256 * (n2 >> 7) + 128 + (n2 & 127); }
    const int h = n >> 8, j = n & 255; return ((j < 128) ? 0 : 1024) + h * 128 + (j & 127);
}
__device__ __forceinline__ void tr_item(const float* W, int K, int N, bf16_t* WT, int ldk, int koff, int mode, LAS float* scr, int item, int lane) {
    const int nblk = N / 32, kb = item / nblk, nb = item % nblk, k0 = 64 * kb, n0 = 32 * nb;
#pragma unroll 8
    for (int i = 0; i < 32; ++i) { const int kk = 2 * i + (lane >> 5); scr[kk * 33 + (lane & 31)] = W[(size_t)(k0 + kk) * N + n0 + (lane & 31)]; }
    asm volatile("s_waitcnt lgkmcnt(0)" ::: "memory");
    const int c = lane & 7;
#pragma unroll
    for (int j = 0; j < 4; ++j) { const int n = (lane >> 3) + 8 * j; const LAS float* s = scr + (8 * c) * 33 + n;
        u32x4 o; o.x = f2bf(s[0 * 33]) | (f2bf(s[1 * 33]) << 16); o.y = f2bf(s[2 * 33]) | (f2bf(s[3 * 33]) << 16); o.z = f2bf(s[4 * 33]) | (f2bf(s[5 * 33]) << 16); o.w = f2bf(s[6 * 33]) | (f2bf(s[7 * 33]) << 16);
        *(u32x4*)(WT + (size_t)tr_map(mode, n0 + n) * ldk + koff + k0 + 8 * c) = o; }
    asm volatile("s_waitcnt lgkmcnt(0)" ::: "memory");
}
__device__ __forceinline__ void row_to_bf16(const float* xrow, const float* gain, bf16_t* orow, bool norm, int lane) {
    const f32x4* xr = (const f32x4*)xrow + lane; const f32x4* gr = (const f32x4*)gain + lane;
    f32x4 v[4]; float s = 0.f;
#pragma unroll
    for (int j = 0; j < 4; ++j) { v[j] = xr[64 * j]; s += (v[j].x * v[j].x + v[j].y * v[j].y) + (v[j].z * v[j].z + v[j].w * v[j].w); }
    float r = 1.0f;
    if (norm) r = rsqrtf(wave_sum(s) * (1.0f / DM) + EPS);
    u32x2* o8 = (u32x2*)orow + lane;
#pragma unroll
    for (int j = 0; j < 4; ++j) { const f32x4 g = gr[64 * j]; u32x2 w; w.x = pk2(v[j].x * r * g.x, v[j].y * r * g.y); w.y = pk2(v[j].z * r * g.z, v[j].w * r * g.w); o8[64 * j] = w; }
}

__device__ __forceinline__ void prologue(LAS unsigned char* lds, int G, int bid) {
    int tid_l = threadIdx.x; asm volatile("" : "+v"(tid_l));
    const int tid = tid_l, wave = tid >> 6, lane = tid & 63;
    LAS float* scr = (LAS float*)(lds + wave * 16384);
    const int gw = bid * 8 + wave, NGW = G * 8;
    { float* z = (float*)(karg_ws() + WS_SSQ_MIX); for (int i = bid * 512 + tid; i < 4 * T; i += G * 512) z[i] = 0.f; }
    { float* z = (float*)(karg_ws() + WS_SSQO); for (int i = bid * 512 + tid; i < 8 * T; i += G * 512) z[i] = 0.f; }
    constexpr int I0 = 16 * 176, I1 = 44 * 32, I2 = 16 * 150, I3 = 16 * 64, I4 = 6 * 48, I5 = 4 * 64, I6 = 16 * 32;
    constexpr int NITEMS = 2 * I0 + 2 * I1 + I2 + I3 + I4 + I5 + 3 * I6;
    for (int it = gw; it < NITEMS; it += NGW) {
        int r = it;
        if (r < I0) { tr_item(karg_in(3), 1024, 5632, (bf16_t*)(karg_ws() + WS_W1IN), 1024, 0, 1, scr, r, lane); continue; } r -= I0;
        if (r < I0) { tr_item(karg_in(21), 1024, 5632, (bf16_t*)(karg_ws() + WS_W2IN), 1024, 0, 1, scr, r, lane); continue; } r -= I0;
        if (r < I1) { tr_item(karg_in(4), 2816, 1024, (bf16_t*)(karg_ws() + WS_W1OUT), 2816, 0, 0, scr, r, lane); continue; } r -= I1;
        if (r < I1) { tr_item(karg_in(22), 2816, 1024, (bf16_t*)(karg_ws() + WS_W2OUT), 2816, 0, 0, scr, r, lane); continue; } r -= I1;
        if (r < I2) { tr_item(karg_in(6), 1024, 4800, (bf16_t*)(karg_ws() + WS_WIN), 1024, 0, 0, scr, r, lane); continue; } r -= I2;
        if (r < I3) { tr_item(karg_in(17), 1024, 2048, (bf16_t*)(karg_ws() + WS_WMG), 1024, 0, 0, scr, r, lane); continue; } r -= I3;
        if (r < I4) { tr_item(karg_in(11), 384, 1536, (bf16_t*)(karg_ws() + WS_WQ), 384, 0, 0, scr, r, lane); continue; } r -= I4;
        if (r < I5) { tr_item(karg_in(13), 256, 2048, (bf16_t*)(karg_ws() + WS_WKV), 256, 0, 2, scr, r, lane); continue; } r -= I5;
        if (r < I6) { tr_item(karg_in(16), 1024, 1024, (bf16_t*)(karg_ws() + WS_WBR), 2048, 0, 0, scr, r, lane); continue; } r -= I6;
        if (r < I6) { tr_item(karg_in(9), 1024, 1024, (bf16_t*)(karg_ws() + WS_WBR), 2048, 1024, 0, scr, r, lane); continue; } r -= I6;
        tr_item(karg_in(19), 1024, 1024, (bf16_t*)(karg_ws() + WS_WOUT), 1024, 0, 0, scr, r, lane);
    }
    bf16_t* u1 = (bf16_t*)(karg_ws() + WS_R3);
    for (int m = gw; m < T; m += NGW) row_to_bf16(karg_in(0) + (size_t)m * DM, karg_in(2), u1 + (size_t)m * DM, true, lane);
}

__device__ __forceinline__ void hg_prepass(LAS unsigned char* lds, bf16_t* QF, const float* lbtab, bf16_t* P, float* Dg, int G, int bid) {
    int tid_l = threadIdx.x; asm volatile("" : "+v"(tid_l));
    const int tid = tid_l, wave = tid >> 6, lane = tid & 63, k = tid & 127, tq = tid >> 7, fr = lane & 15, fq = lane >> 4;
    constexpr int PP_BUF = 2048 + 2 * 32 * 136 * 2;
    bf16_t nqr[8], nfr[8];
    if (bid < 16384) { const int h = bid & 7, bc = bid >> 3; const bf16_t* qp = QF + (size_t)(bc * 32 + 8 * tq) * 2048 + 128 * h + k;
#pragma unroll
        for (int j = 0; j < 8; ++j) { nqr[j] = qp[(size_t)j * 2048]; nfr[j] = qp[(size_t)j * 2048 + 1024]; } }
    int it = 0, hprev = -1; float lb = 0.f, omlb = 0.f;
    for (int u = bid; u < 16384; u += G, ++it) {
        LAS float* seg = (LAS float*)(lds + (it & 1) * PP_BUF);
        LAS bf16_t* Qs = (LAS bf16_t*)(lds + (it & 1) * PP_BUF + 2048);
        LAS bf16_t* Ks = Qs + 32 * 136;
        const int h = u & 7, bc = u >> 3, r0 = bc * 32;
        if (h != hprev) {
            const float t0 = lbtab[128 * h + k], t1 = lbtab[1024 + 128 * h + k], mx = fmaxf(t0, t1);
            const float e0 = __expf(t0 - mx), e1 = __expf(t1 - mx);
            lb = e0 / (e0 + e1); omlb = e1 / (e0 + e1); hprev = h;
        }
        bf16_t* qp = QF + (size_t)(r0 + 8 * tq) * 2048 + 128 * h + k;
        float zq[8], zf[8];
#pragma unroll
        for (int j = 0; j < 8; ++j) { zq[j] = bf2f(nqr[j]); zf[j] = bf2f(nfr[j]); }
        { const int un = u + G;
          if (un < 16384) { const int hn = un & 7, bcn = un >> 3; const bf16_t* qn = QF + (size_t)(bcn * 32 + 8 * tq) * 2048 + 128 * hn + k;
#pragma unroll
              for (int j = 0; j < 8; ++j) { nqr[j] = qn[(size_t)j * 2048]; nfr[j] = qn[(size_t)j * 2048 + 1024]; } } }
        float cl[8], kk[8], qs[8]; float run = 0.f;
#pragma unroll
        for (int j = 0; j < 8; ++j) {
            const float z = zf[j], e = __expf(-z), sg = fast_rcp(1.0f + e);
            const float f = lb + omlb * sg;
            kk[j] = 1.0f - f;
            run += __builtin_amdgcn_logf(f); cl[j] = run;
            qs[j] = silu_f(zq[j]);
        }
        seg[tq * 128 + k] = run;
        LDS_BARRIER();
        const float s0 = seg[k], s1 = seg[128 + k], s2 = seg[256 + k], s3 = seg[384 + k];
        const float prefix = (tq > 0 ? s0 : 0.f) + (tq > 1 ? s1 : 0.f) + (tq > 2 ? s2 : 0.f);
        const float cum_r = s0 + s1, cum_e = cum_r + s2 + s3;
        unsigned kb[8];
        const float Erc = __builtin_amdgcn_exp2f(cum_r), Drc = __builtin_amdgcn_exp2f(cum_e - cum_r);
#pragma unroll
        for (int j = 0; j < 8; ++j) {
            const float d = prefix + cl[j] - cum_r;
            const float E1 = __builtin_amdgcn_exp2f(d), E2 = __builtin_amdgcn_exp2f(-d);
            const float qt = qs[j] * E1, kt = kk[j] * E2;
            qp[(size_t)j * 2048] = (bf16_t)f2bf(qt * Erc);
            kb[j] = f2bf(kt * Drc);
            Qs[(8 * tq + j) * 136 + k] = (bf16_t)f2bf(qt); Ks[(8 * tq + j) * 136 + k] = (bf16_t)f2bf(kt);
        }
        { u32x4 w; w.x = kb[0] | (kb[1] << 16); w.y = kb[2] | (kb[3] << 16); w.z = kb[4] | (kb[5] << 16); w.w = kb[6] | (kb[7] << 16);
          *(u32x4*)(QF + (size_t)(r0 + (k >> 2)) * 2048 + 1024 + 128 * h + (k & 3) * 32 + 8 * tq) = w; }
        if (tq == 0) Dg[(size_t)bc * 1024 + 128 * h + k] = __builtin_amdgcn_exp2f(cum_e);
        LDS_BARRIER();
        if (wave < 3) {
            const int tt = wave > 0 ? 1 : 0, ss = wave == 2 ? 1 : 0;
            f32x4 acc = (f32x4){0.f, 0.f, 0.f, 0.f};
#pragma unroll
            for (int k4 = 0; k4 < 4; ++k4) {
                const bf16x8 a = *(const LAS bf16x8*)(Qs + (16 * tt + fr) * 136 + 32 * k4 + 8 * fq);
                const bf16x8 b = *(const LAS bf16x8*)(Ks + (16 * ss + fr) * 136 + 32 * k4 + 8 * fq);
                acc = __builtin_amdgcn_mfma_f32_16x16x32_bf16(a, b, acc, 0, 0, 0);
            }
#pragma unroll
            for (int i = 0; i < 4; ++i) { const int t = 16 * tt + 4 * fq + i, s = 16 * ss + fr;
                const float v = (s <= t) ? acc[i] : 0.f;
                P[(size_t)u * 1024 + t * 32 + s] = (bf16_t)f2bf(v); }
        }
    }
    LDS_BARRIER();
}

constexpr int H3_QP = 272, H3_KP = 80, H3_PP = 80, H3_VP = 80;
constexpr int H3_Q = 0, H3_K = H3_Q + 32 * H3_QP, H3_P = H3_K + 128 * H3_KP, H3_V = H3_P + 32 * H3_PP, H3_D = H3_V + 32 * H3_VP, H3_STAGE = H3_D + 512;
constexpr int H3_O = 2 * H3_STAGE, H3_OBYTES = 4 * 32 * 32 * 4;
static_assert(H3_O + 2 * H3_OBYTES <= 131072 && H3_STAGE % 16 == 0, "recurrence LDS map");
__device__ __forceinline__ void hg_recur(LAS unsigned char* lds, const bf16_t* QF, bf16_t* IG, const bf16_t* P, const float* Dg, float* ssq_o, int G, int bid) {
    int tid_l = threadIdx.x; asm volatile("" : "+v"(tid_l));
    const int tid = tid_l, w = tid >> 6, lane = tid & 63, lv = lane & 15, fq = lane >> 4, vt = w & 1, kq = w >> 1;
    const int srow = tid >> 4, sch = tid & 15;
    for (int u = bid; u < 256; u += G) {
        const int b = u >> 5, h = (u >> 2) & 7, vq = u & 3;
        f32x4 S[2];
        S[0] = (f32x4){0.f, 0.f, 0.f, 0.f}; S[1] = S[0];
#define H3_FLUSH(cc_, stt_) do { \
            { const LAS float* ot = (const LAS float*)(lds + H3_O + (stt_) * H3_OBYTES) + (tid >> 4) * 32 + 2 * (tid & 15); \
              typedef float f32x2v __attribute__((ext_vector_type(2))); \
              const f32x2v p0 = *(const LAS f32x2v*)ot, p1 = *(const LAS f32x2v*)(ot + 1024), p2 = *(const LAS f32x2v*)(ot + 2048), p3 = *(const LAS f32x2v*)(ot + 3072); \
              const float x0 = (p0.x + p1.x) + (p2.x + p3.x), x1 = (p0.y + p1.y) + (p2.y + p3.y); \
              const size_t row = (size_t)(b * 256 + (cc_)) * 32 + (tid >> 4); \
              *(unsigned*)(IG + row * 2048 + 128 * h + 32 * vq + 2 * (tid & 15)) = pk2(x0, x1); \
              float sq = x0 * x0 + x1 * x1; \
              sq += __builtin_bit_cast(float, __builtin_amdgcn_update_dpp(0, __builtin_bit_cast(int, sq), 0x128, 0xf, 0xf, true)); \
              sq += __builtin_bit_cast(float, __builtin_amdgcn_update_dpp(0, __builtin_bit_cast(int, sq), 0x124, 0xf, 0xf, true)); \
              sq += __builtin_bit_cast(float, __builtin_amdgcn_update_dpp(0, __builtin_bit_cast(int, sq), 0x122, 0xf, 0xf, true)); \
              sq += __builtin_bit_cast(float, __builtin_amdgcn_update_dpp(0, __builtin_bit_cast(int, sq), 0x121, 0xf, 0xf, true)); \
              if ((tid & 15) == 0) atomicAdd(ssq_o + row * 8 + h, sq); } } while (0)
        u32x4 rqA, rkA, rxA, rqB, rkB, rxB;
#define H3_GLOAD(X, c_) do { const int bc_ = b * 256 + (c_); const size_t ro_ = (size_t)(bc_ * 32 + srow) * 2048 + 128 * h + 8 * sch; \
            rq##X = *(const u32x4*)(QF + ro_); rk##X = *(const u32x4*)(QF + ro_ + 1024); \
            if (tid < 128) rx##X = *(const u32x4*)(P + ((size_t)bc_ * 8 + h) * 1024 + 8 * tid); \
            else if (tid < 256) rx##X = *(const u32x4*)(IG + (size_t)(bc_ * 32 + ((tid - 128) >> 2)) * 2048 + 128 * h + 32 * vq + 8 * (tid & 3)); \
            else if (tid < 288) rx##X = *(const u32x4*)(Dg + (size_t)bc_ * 1024 + 128 * h + 4 * (tid - 256)); } while (0)
#define H3_LSTORE(X, st_) do { LAS unsigned char* sb_ = lds + (st_) * H3_STAGE; \
            *(LAS u32x4*)(sb_ + H3_Q + srow * H3_QP + sch * 16) = rq##X; \
            *(LAS u32x4*)(sb_ + H3_K + (4 * srow + (sch >> 2)) * H3_KP + (sch & 3) * 16) = rk##X; \
            if (tid < 128) *(LAS u32x4*)(sb_ + H3_P + (tid >> 2) * H3_PP + (tid & 3) * 16) = rx##X; \
            else if (tid < 256) *(LAS u32x4*)(sb_ + H3_V + ((tid - 128) >> 2) * H3_VP + (tid & 3) * 16) = rx##X; \
            else if (tid < 288) *(LAS u32x4*)(sb_ + H3_D + (tid - 256) * 16) = rx##X; } while (0)
        H3_GLOAD(A, 0);
        H3_GLOAD(B, 1);
        H3_LSTORE(A, 0);
        LDS_BARRIER();
        for (int c2 = 0; c2 < 256; c2 += 2) {
#pragma unroll
          for (int par = 0; par < 2; ++par) {
            const int c = c2 + par, st = par;
            if (c + 1 < 256) { if (par == 0) H3_LSTORE(B, 1); else H3_LSTORE(A, 0); }
            if (c + 2 < 256) { if (par == 0) H3_GLOAD(A, c + 2); else H3_GLOAD(B, c + 2); }
            LAS unsigned char* sb = lds + st * H3_STAGE;
            u32x2 vfu[2];
#pragma unroll
            for (int ss = 0; ss < 2; ++ss) {
                const LAS unsigned char* vp = sb + H3_V + (16 * ss + 4 * fq) * H3_VP + (16 * vt + lv) * 2;
                const unsigned e0 = *(const LAS bf16_t*)(vp), e1 = *(const LAS bf16_t*)(vp + H3_VP), e2 = *(const LAS bf16_t*)(vp + 2 * H3_VP), e3 = *(const LAS bf16_t*)(vp + 3 * H3_VP);
                vfu[ss].x = e0 | (e1 << 16); vfu[ss].y = e2 | (e3 << 16);
            }
            const s16x4 vf0 = __builtin_bit_cast(s16x4, vfu[0]), vf1 = __builtin_bit_cast(s16x4, vfu[1]);
            if (c > 0) H3_FLUSH(c - 1, st ^ 1);
            f32x4 o0 = (f32x4){0.f, 0.f, 0.f, 0.f}, o1 = o0;
#pragma unroll
            for (int k2 = 0; k2 < 2; ++k2) {
                u32x2 sbu; sbu.x = pk2(S[k2][0], S[k2][1]); sbu.y = pk2(S[k2][2], S[k2][3]);
                const s16x4 Sb = __builtin_bit_cast(s16x4, sbu);
                const LAS unsigned char* qp = sb + H3_Q + lv * H3_QP + (32 * kq + 16 * k2 + 4 * fq) * 2;
                const s16x4 a0 = *(const LAS s16x4*)qp, a1 = *(const LAS s16x4*)(qp + 16 * H3_QP);
                o0 = __builtin_amdgcn_mfma_f32_16x16x16bf16_1k(a0, Sb, o0, 0, 0, 0);
                o1 = __builtin_amdgcn_mfma_f32_16x16x16bf16_1k(a1, Sb, o1, 0, 0, 0);
            }
            if (kq < 3) {
                const LAS unsigned char* pp = sb + H3_P + (16 * (kq > 0 ? 1 : 0) + lv) * H3_PP + (16 * (kq == 2 ? 1 : 0) + 4 * fq) * 2;
                const s16x4 a = *(const LAS s16x4*)pp;
                if (kq == 0) o0 = __builtin_amdgcn_mfma_f32_16x16x16bf16_1k(a, vf0, o0, 0, 0, 0);
                else if (kq == 1) o1 = __builtin_amdgcn_mfma_f32_16x16x16bf16_1k(a, vf0, o1, 0, 0, 0);
                else o1 = __builtin_amdgcn_mfma_f32_16x16x16bf16_1k(a, vf1, o1, 0, 0, 0);
            }
#pragma unroll
            for (int k2 = 0; k2 < 2; ++k2) {
                const f32x4 dd = *(const LAS f32x4*)(sb + H3_D + (32 * kq + 16 * k2 + 4 * fq) * 4);
                S[k2] = S[k2] * dd;
                const LAS unsigned char* kp = sb + H3_K + (32 * kq + 16 * k2 + lv) * H3_KP + 4 * fq * 2;
                const s16x4 a0 = *(const LAS s16x4*)kp, a1 = *(const LAS s16x4*)(kp + 32);
                S[k2] = __builtin_amdgcn_mfma_f32_16x16x16bf16_1k(a0, vf0, S[k2], 0, 0, 0);
                S[k2] = __builtin_amdgcn_mfma_f32_16x16x16bf16_1k(a1, vf1, S[k2], 0, 0, 0);
            }
            { LAS float* ot = (LAS float*)(lds + H3_O + st * H3_OBYTES) + kq * 1024 + 16 * vt + lv;
#pragma unroll
              for (int i = 0; i < 4; ++i) { ot[(4 * fq + i) * 32] = o0[i]; ot[(16 + 4 * fq + i) * 32] = o1[i]; } }
            LDS_BARRIER();
          }
        }
        H3_FLUSH(255, 1);
#undef H3_FLUSH
#undef H3_GLOAD
#undef H3_LSTORE
        LDS_BARRIER();
    }
}

__device__ __forceinline__ void hg_norm_pass(bf16_t* IG, const float* ssq_o, const float* gain, int G, int bid) {
    int tid_l = threadIdx.x; asm volatile("" : "+v"(tid_l));
    const int tid = tid_l, wave = tid >> 6, lane = tid & 63, gw = bid * 8 + wave, NGW = G * 8;
    float gv[16];
#pragma unroll
    for (int j = 0; j < 16; ++j) gv[j] = gain[((16 * lane) & 127) + j];
    for (int row = gw; row < T; row += NGW) {
        bf16_t* rp = IG + (size_t)row * 2048 + 16 * lane;
        const u32x4 a0 = *(const u32x4*)rp, a1 = *(const u32x4*)(rp + 8), g0 = *(const u32x4*)(rp + 1024), g1 = *(const u32x4*)(rp + 1032);
        const float r = rsqrtf(ssq_o[(size_t)row * 8 + (lane >> 3)] * (1.0f / 128.0f) + EPS);
        u32x4 w0, w1;
#pragma unroll
        for (int q = 0; q < 4; ++q) {
            const float x0 = __uint_as_float(a0[q] << 16), x1 = __uint_as_float(a0[q] & 0xffff0000u), y0 = __uint_as_float(a1[q] << 16), y1 = __uint_as_float(a1[q] & 0xffff0000u);
            const float s0 = silu_f(__uint_as_float(g0[q] << 16)), s1 = silu_f(__uint_as_float(g0[q] & 0xffff0000u)), t0 = silu_f(__uint_as_float(g1[q] << 16)), t1 = silu_f(__uint_as_float(g1[q] & 0xffff0000u));
            w0[q] = pk2(x0 * r * gv[2 * q] * s0, x1 * r * gv[2 * q + 1] * s1);
            w1[q] = pk2(y0 * r * gv[8 + 2 * q] * t0, y1 * r * gv[8 + 2 * q + 1] * t1);
        }
        *(u32x4*)(rp + 1024) = w0; *(u32x4*)(rp + 1032) = w1;
    }
}

__device__ __forceinline__ void fin_head(const u32x4 a0, const u32x4 a1, const u32x2 r1, const u32x2 r2, const float (&gn)[16], const float (&g1)[4], const float (&g2)[4],
                                         const float (&sn)[4], const float (&cs)[4], float scale, u32x4& o0, u32x4& o1, u32x2& q1, u32x2& q2) {
    float v[16], x1[4], x2[4];
#pragma unroll
    for (int q = 0; q < 4; ++q) { v[2 * q] = __uint_as_float(a0[q] << 16); v[2 * q + 1] = __uint_as_float(a0[q] & 0xffff0000u); v[8 + 2 * q] = __uint_as_float(a1[q] << 16); v[8 + 2 * q + 1] = __uint_as_float(a1[q] & 0xffff0000u); }
#pragma unroll
    for (int q = 0; q < 2; ++q) { x1[2 * q] = __uint_as_float(r1[q] << 16); x1[2 * q + 1] = __uint_as_float(r1[q] & 0xffff0000u); x2[2 * q] = __uint_as_float(r2[q] << 16); x2[2 * q + 1] = __uint_as_float(r2[q] & 0xffff0000u); }
    float ss = 0.f;
#pragma unroll
    for (int j = 0; j < 16; ++j) ss += v[j] * v[j];
#pragma unroll
    for (int j = 0; j < 4; ++j) ss += x1[j] * x1[j] + x2[j] * x2[j];
    ss += __shfl_xor(ss, 1); ss += __shfl_xor(ss, 2); ss += __shfl_xor(ss, 4);
    const float r = rsqrtf(ss * (1.0f / 192.0f) + EPS) * scale;
#pragma unroll
    for (int j = 0; j < 16; ++j) v[j] = v[j] * r * gn[j];
    float z1[4], z2[4];
#pragma unroll
    for (int j = 0; j < 4; ++j) { const float y1 = x1[j] * r * g1[j], y2 = x2[j] * r * g2[j]; z1[j] = y1 * cs[j] - y2 * sn[j]; z2[j] = y2 * cs[j] + y1 * sn[j]; }
#pragma unroll
    for (int q = 0; q < 4; ++q) { o0[q] = pk2(v[2 * q], v[2 * q + 1]); o1[q] = pk2(v[8 + 2 * q], v[8 + 2 * q + 1]); }
#pragma unroll
    for (int q = 0; q < 2; ++q) { q1[q] = pk2(z1[2 * q], z1[2 * q + 1]); q2[q] = pk2(z2[2 * q], z2[2 * q + 1]); }
}
__device__ __forceinline__ void mla_finalize(bf16_t* Q, bf16_t* KF, const bf16_t* kpe, const int* positions, const float* gq, const float* gk, int G, int bid) {
    int tid_l = threadIdx.x; asm volatile("" : "+v"(tid_l));
    const int tid = tid_l, wave = tid >> 6, lane = tid & 63, h = lane >> 3, p = lane & 7;
    const int gw = bid * 8 + wave, NGW = G * 8;
    float gqn[16], gq1[4], gq2[4], gkn[16], gk1[4], gk2[4], invf[4];
#pragma unroll
    for (int j = 0; j < 16; ++j) { gqn[j] = gq[16 * p + j]; gkn[j] = gk[16 * p + j]; }
#pragma unroll
    for (int j = 0; j < 4; ++j) { gq1[j] = gq[128 + 4 * p + j]; gq2[j] = gq[160 + 4 * p + j]; gk1[j] = gk[128 + 4 * p + j]; gk2[j] = gk[160 + 4 * p + j];
        invf[j] = exp2f(-(float)(4 * p + j) * 0.41524101186092029f); }
    for (int row = gw; row < T; row += NGW) {
        const float pos = (float)positions[row];
        float sn[4], cs[4];
#pragma unroll
        for (int j = 0; j < 4; ++j) { const float ang = pos * invf[j]; const double rev = (double)ang * 0.15915494309189535; const float frc = (float)(rev - rint(rev));
            sn[j] = __builtin_amdgcn_sinf(frc); cs[j] = __builtin_amdgcn_cosf(frc); }
        { bf16_t* kb = KF + (size_t)row * 1536 + 192 * h; const bf16_t* kp = kpe + (size_t)row * 64;
          const u32x4 a0 = *(const u32x4*)(kb + 16 * p), a1 = *(const u32x4*)(kb + 16 * p + 8); const u32x2 r1 = *(const u32x2*)(kp + 4 * p), r2 = *(const u32x2*)(kp + 32 + 4 * p);
          u32x4 o0, o1; u32x2 q1, q2;
          fin_head(a0, a1, r1, r2, gkn, gk1, gk2, sn, cs, 1.0f, o0, o1, q1, q2);
          *(u32x4*)(kb + 16 * p) = o0; *(u32x4*)(kb + 16 * p + 8) = o1; *(u32x2*)(kb + 128 + 4 * p) = q1; *(u32x2*)(kb + 160 + 4 * p) = q2; }
    }
}

typedef __amdgpu_buffer_rsrc_t bufrsrc_t;
constexpr int AT_KP = 400, AT_VP = 144, AT_KBYTES = 64 * AT_KP, AT_STAGE = AT_KBYTES + 128 * AT_VP;
template <int MODE> __device__ __forceinline__ void attn_phase(LAS unsigned char* lds, const bf16_t* Q, const bf16_t* KF, const bf16_t* VT, bf16_t* O, const int* positions, const float* gq, int G, int bid) {
    int tid_l = threadIdx.x; asm volatile("" : "+v"(tid_l));
    const int tid = tid_l, w = tid >> 6, lane = tid & 63, lq = lane & 31, hi = lane >> 5;
    const unsigned kvo = (unsigned)((tid >> 3) * 1536 + 8 * (tid & 7));
    const unsigned vvo = (unsigned)((tid >> 3) * T + 8 * (tid & 7));
    const unsigned klo = (unsigned)((tid >> 3) * AT_KP + (tid & 7) * 16);
    const unsigned vlo = (unsigned)(AT_KBYTES + (tid >> 3) * AT_VP + ((tid & 7) >> 1) * 32 + (tid & 1) * 8);
    for (int it = bid; it < 1024; it += G) {
        const int bh = it >> 4, pp = it & 15, b = bh >> 3, h = bh & 7;
        for (int half = 0; half < 2; ++half) {
            const int j = half ? 31 - pp : pp;
            const int ntiles = 4 * j + 4, my_last = 4 * j + (w >> 1);
            const size_t qrow = (size_t)b * SEQ + 256 * j + 32 * w + lq;
            bf16x8 qf[12];
#pragma unroll
            for (int kk = 0; kk < 12; ++kk) qf[kk] = *(const bf16x8*)(Q + qrow * 1536 + 192 * h + 16 * kk + 8 * hi);
            {
                float ss = 0.f;
#pragma unroll
                for (int kk = 0; kk < 12; ++kk)
#pragma unroll
                    for (int j = 0; j < 8; ++j) { const float v = bf2f((bf16_t)qf[kk][j]); ss += v * v; }
                ss += __shfl_xor(ss, 32);
                const float r = rsqrtf(ss * (1.0f / 192.0f) + EPS) * QSCALE;
#pragma unroll
                for (int kk = 0; kk < 8; ++kk) {
                    const f32x4 g0 = *(const f32x4*)(gq + 16 * kk + 8 * hi), g1 = *(const f32x4*)(gq + 16 * kk + 8 * hi + 4);
#pragma unroll
                    for (int q2 = 0; q2 < 4; ++q2) {
                        const float a = bf2f((bf16_t)qf[kk][2 * q2]) * r * ((q2 < 2) ? g0[2 * q2] : g1[2 * q2 - 4]);
                        const float c = bf2f((bf16_t)qf[kk][2 * q2 + 1]) * r * ((q2 < 2) ? g0[2 * q2 + 1] : g1[2 * q2 - 3]);
                        const unsigned pk = pk2(a, c); qf[kk][2 * q2] = (short)(pk & 0xffff); qf[kk][2 * q2 + 1] = (short)(pk >> 16);
                    }
                }
                const float pos = (float)positions[qrow];
#pragma unroll
                for (int kk = 8; kk < 10; ++kk) {
                    const f32x4 ga0 = *(const f32x4*)(gq + 16 * kk + 8 * hi), ga1 = *(const f32x4*)(gq + 16 * kk + 8 * hi + 4);
                    const f32x4 gb0 = *(const f32x4*)(gq + 16 * kk + 32 + 8 * hi), gb1 = *(const f32x4*)(gq + 16 * kk + 32 + 8 * hi + 4);
                    float z1[8], z2[8];
#pragma unroll
                    for (int j = 0; j < 8; ++j) {
                        const int i = 16 * (kk - 8) + 8 * hi + j;
                        const float ang = pos * exp2f(-(float)i * 0.41524101186092029f);
                        const double rev = (double)ang * 0.15915494309189535; const float frc = (float)(rev - rint(rev));
                        const float sn = __builtin_amdgcn_sinf(frc), cs = __builtin_amdgcn_cosf(frc);
                        const float y1 = bf2f((bf16_t)qf[kk][j]) * r * ((j < 4) ? ga0[j] : ga1[j - 4]);
                        const float y2 = bf2f((bf16_t)qf[kk + 2][j]) * r * ((j < 4) ? gb0[j] : gb1[j - 4]);
                        z1[j] = y1 * cs - y2 * sn; z2[j] = y2 * cs + y1 * sn;
                    }
#pragma unroll
                    for (int q2 = 0; q2 < 4; ++q2) {
                        const unsigned p1 = pk2(z1[2 * q2], z1[2 * q2 + 1]), p2 = pk2(z2[2 * q2], z2[2 * q2 + 1]);
                        qf[kk][2 * q2] = (short)(p1 & 0xffff); qf[kk][2 * q2 + 1] = (short)(p1 >> 16);
                        qf[kk + 2][2 * q2] = (short)(p2 & 0xffff); qf[kk + 2][2 * q2 + 1] = (short)(p2 >> 16);
                    }
                }
            }
            f32x16 o[4];
#pragma unroll
            for (int db = 0; db < 4; ++db)
#pragma unroll
                for (int i = 0; i < 16; ++i) o[db][i] = 0.f;
            float mrun = 0.f, lsum = 0.f;
            const bf16_t* kg = KF + (size_t)b * SEQ * 1536 + 192 * h;
            const bf16_t* vg = VT + (size_t)(128 * h) * T + (size_t)b * SEQ;
            u32x4 kr[3], vr[2];
            const bufrsrc_t krs = __builtin_amdgcn_make_buffer_rsrc((void*)kg, 0, 0x7fffffff, 0x00020000), vrs = __builtin_amdgcn_make_buffer_rsrc((void*)vg, 0, 0x7fffffff, 0x00020000);
#define AT_GLOAD_K(kt_) do { const int so_ = ((MODE == 1) ? 0 : (kt_)) * (64 * 1536 * 2); \
                _Pragma("unroll") for (int i = 0; i < 3; ++i) kr[i] = __builtin_bit_cast(u32x4, __builtin_amdgcn_raw_buffer_load_b128(krs, (int)(kvo * 2u) + 128 * i, so_, 0)); } while (0)
#define AT_GLOAD_V(kt_) do { const int so_ = ((MODE == 1) ? 0 : (kt_)) * 128; \
                vr[0] = __builtin_bit_cast(u32x4, __builtin_amdgcn_raw_buffer_load_b128(vrs, (int)(vvo * 2u), so_, 0)); \
                vr[1] = __builtin_bit_cast(u32x4, __builtin_amdgcn_raw_buffer_load_b128(vrs, (int)(vvo * 2u), so_ + 64 * T * 2, 0)); } while (0)
#define AT_LSTORE_K(buf_) do { LAS unsigned char* nb_ = lds + (buf_) * AT_STAGE; \
                _Pragma("unroll") for (int i = 0; i < 3; ++i) *(LAS u32x4*)(nb_ + klo + 128 * i) = kr[i]; } while (0)
#define AT_LSTORE_V(buf_) do { LAS unsigned char* nb_ = lds + (buf_) * AT_STAGE; \
                *(LAS u32x2*)(nb_ + vlo) = (u32x2){vr[0].x, vr[0].y}; *(LAS u32x2*)(nb_ + vlo + 16) = (u32x2){vr[0].z, vr[0].w}; \
                *(LAS u32x2*)(nb_ + vlo + 64 * AT_VP) = (u32x2){vr[1].x, vr[1].y}; *(LAS u32x2*)(nb_ + vlo + 64 * AT_VP + 16) = (u32x2){vr[1].z, vr[1].w}; } while (0)
#define AT_LSTORE(buf_) do { AT_LSTORE_K(buf_); AT_LSTORE_V(buf_); } while (0)
            AT_GLOAD_K(0); AT_GLOAD_V(0);
            AT_LSTORE(0);
            __syncthreads();
            for (int kt = 0; kt < ntiles; ++kt) {
                const bool more = (kt + 1 < ntiles);
                if (more && MODE < 3) { AT_GLOAD_K(kt + 1); AT_GLOAD_V(kt + 1); }
                if (kt <= my_last) {
                    LAS unsigned char* kb = lds + (kt & 1) * AT_STAGE; LAS unsigned char* vb = kb + AT_KBYTES;
#define AT_RESCALE(EXTRA) do { const float d_ = fmaxf(mx, 0.f), alpha_ = __builtin_amdgcn_exp2f(-d_); mrun += d_; lsum *= alpha_; \
                        _Pragma("unroll") for (int db = 0; db < 4; ++db) _Pragma("unroll") for (int i = 0; i < 16; ++i) o[db][i] *= alpha_; EXTRA } while (0)
                    f32x16 s0, s1;
#pragma unroll
                    for (int i = 0; i < 16; ++i) s0[i] = -mrun;
                    bf16x8 fr[8], fr2[4];
#pragma unroll
                    for (int kk = 0; kk < 8; ++kk) fr[kk] = *(const LAS bf16x8*)(kb + lq * AT_KP + (16 * kk + 8 * hi) * 2);
                    __builtin_amdgcn_sched_barrier(0);
#pragma unroll
                    for (int kk = 0; kk < 4; ++kk) s0 = __builtin_amdgcn_mfma_f32_32x32x16_bf16(fr[kk], qf[kk], s0, 0, 0, 0);
                    __builtin_amdgcn_sched_barrier(0);
#pragma unroll
                    for (int kk = 8; kk < 12; ++kk) fr2[kk - 8] = *(const LAS bf16x8*)(kb + lq * AT_KP + (16 * kk + 8 * hi) * 2);
                    __builtin_amdgcn_sched_barrier(0);
#pragma unroll
                    for (int kk = 4; kk < 8; ++kk) s0 = __builtin_amdgcn_mfma_f32_32x32x16_bf16(fr[kk], qf[kk], s0, 0, 0, 0);
#pragma unroll
                    for (int kk = 8; kk < 12; ++kk) s0 = __builtin_amdgcn_mfma_f32_32x32x16_bf16(fr2[kk - 8], qf[kk], s0, 0, 0, 0);
                    __builtin_amdgcn_sched_barrier(0);
#pragma unroll
                    for (int kk = 0; kk < 8; ++kk) fr[kk] = *(const LAS bf16x8*)(kb + (32 + lq) * AT_KP + (16 * kk + 8 * hi) * 2);
                    __builtin_amdgcn_sched_barrier(0);
                    float mx = fmaxf(fmaxf(s0[0], s0[1]), fmaxf(s0[2], s0[3]));
#pragma unroll
                    for (int i = 4; i < 16; i += 2) mx = fmaxf(mx, fmaxf(s0[i], s0[i + 1]));
                    mx = fmaxf(mx, __shfl_xor(mx, 32));
                    if (__any(mx > 6.0f)) AT_RESCALE(_Pragma("unroll") for (int i = 0; i < 16; ++i) s0[i] -= d_;);
#pragma unroll
                    for (int i = 0; i < 16; ++i) s1[i] = -mrun;
                    __builtin_amdgcn_sched_barrier(0);
                    float ps = 0.f;
#pragma unroll
                    for (int kk = 0; kk < 4; ++kk) s1 = __builtin_amdgcn_mfma_f32_32x32x16_bf16(fr[kk], qf[kk], s1, 0, 0, 0);
#pragma unroll
                    for (int i = 0; i < 5; ++i) { s0[i] = __builtin_amdgcn_exp2f(s0[i]); ps += s0[i]; }
#pragma unroll
                    for (int g = 0; g < 4; ++g) { __builtin_amdgcn_sched_group_barrier(0x008, 1, 0); __builtin_amdgcn_sched_group_barrier(0x002, 3, 0); }
                    __builtin_amdgcn_sched_barrier(0);
#pragma unroll
                    for (int kk = 8; kk < 12; ++kk) fr2[kk - 8] = *(const LAS bf16x8*)(kb + (32 + lq) * AT_KP + (16 * kk + 8 * hi) * 2);
                    __builtin_amdgcn_sched_barrier(0);
#pragma unroll
                    for (int kk = 4; kk < 8; ++kk) s1 = __builtin_amdgcn_mfma_f32_32x32x16_bf16(fr[kk], qf[kk], s1, 0, 0, 0);
#pragma unroll
                    for (int kk = 8; kk < 12; ++kk) s1 = __builtin_amdgcn_mfma_f32_32x32x16_bf16(fr2[kk - 8], qf[kk], s1, 0, 0, 0);
#pragma unroll
                    for (int i = 5; i < 16; ++i) { s0[i] = __builtin_amdgcn_exp2f(s0[i]); ps += s0[i]; }
#pragma unroll
                    for (int g = 0; g < 8; ++g) { __builtin_amdgcn_sched_group_barrier(0x008, 1, 0); __builtin_amdgcn_sched_group_barrier(0x002, 3, 0); }
                    __builtin_amdgcn_sched_barrier(0);
                    bf16x8 va[8];
#pragma unroll
                    for (int ks = 0; ks < 2; ++ks)
#pragma unroll
                        for (int db = 0; db < 4; ++db) va[ks * 4 + db] = *(const LAS bf16x8*)(vb + (32 * db + lq) * AT_VP + (16 * ks + 8 * hi) * 2);
                    __builtin_amdgcn_sched_barrier(0);
                    mx = fmaxf(fmaxf(s1[0], s1[1]), fmaxf(s1[2], s1[3]));
#pragma unroll
                    for (int i = 4; i < 16; i += 2) mx = fmaxf(mx, fmaxf(s1[i], s1[i + 1]));
                    mx = fmaxf(mx, __shfl_xor(mx, 32));
                    if (__any(mx > 6.0f)) AT_RESCALE(ps *= alpha_; _Pragma("unroll") for (int i = 0; i < 16; ++i) { s0[i] *= alpha_; s1[i] -= d_; });
                    lsum += ps;
                    bf16x8 pb[2];
#pragma unroll
                    for (int ks = 0; ks < 2; ++ks)
#pragma unroll
                        for (int q = 0; q < 4; ++q) { const unsigned pk = pk2(s0[8 * ks + 2 * q], s0[8 * ks + 2 * q + 1]); pb[ks][2 * q] = (short)(pk & 0xffff); pb[ks][2 * q + 1] = (short)(pk >> 16); }
                    __builtin_amdgcn_sched_barrier(0);
#pragma unroll
                    for (int ks = 0; ks < 2; ++ks)
#pragma unroll
                        for (int db = 0; db < 4; ++db) o[db] = __builtin_amdgcn_mfma_f32_32x32x16_bf16(va[ks * 4 + db], pb[ks], o[db], 0, 0, 0);
                    float ps1 = 0.f;
#pragma unroll
                    for (int i = 0; i < 16; ++i) { s1[i] = __builtin_amdgcn_exp2f(s1[i]); ps1 += s1[i]; }
#pragma unroll
                    for (int g = 0; g < 8; ++g) { __builtin_amdgcn_sched_group_barrier(0x008, 1, 0); __builtin_amdgcn_sched_group_barrier(0x002, 4, 0); }
                    __builtin_amdgcn_sched_barrier(0);
                    lsum += ps1;
#pragma unroll
                    for (int ks = 0; ks < 2; ++ks)
#pragma unroll
                        for (int db = 0; db < 4; ++db) va[ks * 4 + db] = *(const LAS bf16x8*)(vb + (32 * db + lq) * AT_VP + (16 * (ks + 2) + 8 * hi) * 2);
                    if (more && MODE < 3) AT_LSTORE((kt + 1) & 1);
                    __builtin_amdgcn_sched_barrier(0);
#pragma unroll
                    for (int ks = 0; ks < 2; ++ks)
#pragma unroll
                        for (int q = 0; q < 4; ++q) { const unsigned pk = pk2(s1[8 * ks + 2 * q], s1[8 * ks + 2 * q + 1]); pb[ks][2 * q] = (short)(pk & 0xffff); pb[ks][2 * q + 1] = (short)(pk >> 16); }
                    __builtin_amdgcn_sched_barrier(0);
#pragma unroll
                    for (int ks = 0; ks < 2; ++ks)
#pragma unroll
                        for (int db = 0; db < 4; ++db) o[db] = __builtin_amdgcn_mfma_f32_32x32x16_bf16(va[ks * 4 + db], pb[ks], o[db], 0, 0, 0);
#undef AT_RESCALE
                }
                if (more && MODE < 3 && kt > my_last) AT_LSTORE((kt + 1) & 1);
                if (MODE != 4) __syncthreads();
            }
#undef AT_GLOAD_K
#undef AT_GLOAD_V
#undef AT_LSTORE
#undef AT_LSTORE_K
#undef AT_LSTORE_V
            lsum += __shfl_xor(lsum, 32);
            const float inv = 1.0f / lsum;
            int t2 = threadIdx.x; asm volatile("" : "+v"(t2));
            const size_t qrow2 = (size_t)b * SEQ + 256 * j + 32 * (t2 >> 6) + (t2 & 31);
            bf16_t* op = O + qrow2 * 2048 + 128 * h;
#pragma unroll
            for (int db = 0; db < 4; ++db)
#pragma unroll
                for (int g4 = 0; g4 < 4; ++g4) {
                    u32x2 wv; wv.x = pk2(o[db][4 * g4] * inv, o[db][4 * g4 + 1] * inv); wv.y = pk2(o[db][4 * g4 + 2] * inv, o[db][4 * g4 + 3] * inv);
                    *(u32x2*)(op + 32 * db + 8 * g4 + 4 * hi) = wv;
                }
        }
    }
}

#ifndef PH_MASK
#define PH_MASK 0xFFFFF
#endif
__global__ void __launch_bounds__(512, 2) fwd_megakernel(Params p) {
    extern __shared__ __attribute__((aligned(16))) unsigned char lds_raw[];
    LAS unsigned char* lds = (LAS unsigned char*)lds_raw;
    cg::grid_group grid = cg::this_grid();
    const int G = gridDim.x, bid = blockIdx.x;
#define FRESH_LANE_IDS int tid_l = threadIdx.x; asm volatile("" : "+v"(tid_l)); const int wave = tid_l >> 6, lane = tid_l & 63, gw = bid * 8 + wave, NGW = G * 8
#define WSB karg_ws()
#define OUTP karg_out()
#define ssq_mix ((float*)(WSB + WS_SSQ_MIX))
#define ssq_cq ((float*)(WSB + WS_SSQ_CQ))
#define ssq_ckv ((float*)(WSB + WS_SSQ_CKV))
#define ssq2 ((float*)(WSB + WS_SSQ2))
#define R3 ((bf16_t*)(WSB + WS_R3))
#define IG ((bf16_t*)(WSB + WS_IG))
#define QF ((bf16_t*)(WSB + WS_QF))
#define HID ((bf16_t*)(WSB + WS_HID))
#define KF ((bf16_t*)(WSB + WS_KF))
#define cqg ((bf16_t*)(WSB + WS_CQG))
#define ckvg ((bf16_t*)(WSB + WS_CKVG))
#define kpe ((bf16_t*)(WSB + WS_KPE))
#define HB ((bf16_t*)OUTP)
#define HGM (((bf16_t*)OUTP) + (size_t)T * DM)
#define H3 ((bf16_t*)(WSB + 544 * MiB))

    if constexpr (PH_MASK & 1) prologue(lds, G, bid);
    grid.sync();
    if constexpr (PH_MASK & 2) { EpiSwiglu E{HID, nullptr}; run_gemm(lds, R3, (const bf16_t*)(WSB + WS_W1IN), T, 5632, 1024, E, G, bid); }
    grid.sync();
    if constexpr (PH_MASK & 4) { EpiRes<float, bf16_t, 1> E{karg_in(0), HB, HGM, karg_in(5), ssq_mix}; run_gemm(lds, HID, (const bf16_t*)(WSB + WS_W1OUT), T, 1024, DFF, E, G, bid); }
    grid.sync();
    if constexpr (PH_MASK & 8) { EpiIn E{QF, IG, cqg, ckvg, kpe, ssq_mix, ssq_cq, ssq_ckv, karg_in(10), karg_in(12)}; run_gemm(lds, HGM, (const bf16_t*)(WSB + WS_WIN), T, NIN, 1024, E, G, bid); }
    grid.sync();
    if constexpr (PH_MASK & 16) {
        FRESH_LANE_IDS;
        for (int m = gw; m < T; m += NGW) {
            const float rq = rsqrtf(ssq_cq[m] * (1.0f / 384.0f) + EPS), rk = rsqrtf(ssq_ckv[m] * (1.0f / 256.0f) + EPS);
            if (lane < 48) { u32x4* pq = (u32x4*)(cqg + (size_t)m * 384) + lane; u32x4 v = *pq;
#pragma unroll
                for (int q = 0; q < 4; ++q) v[q] = pk2(__uint_as_float(v[q] << 16) * rq, __uint_as_float(v[q] & 0xffff0000u) * rq);
                *pq = v; }
            if (lane < 32) { u32x4* pk = (u32x4*)(ckvg + (size_t)m * 256) + lane; u32x4 v = *pk;
#pragma unroll
                for (int q = 0; q < 4; ++q) v[q] = pk2(__uint_as_float(v[q] << 16) * rk, __uint_as_float(v[q] & 0xffff0000u) * rk);
                *pk = v; }
        }
    }
    if constexpr (PH_MASK & 16) hg_prepass(lds, QF, karg_in(7), (bf16_t*)(WSB + WS_P), (float*)(WSB + WS_ER), G, bid);
    grid.sync();
    if constexpr (PH_MASK & 32) hg_recur(lds, QF, IG, (const bf16_t*)(WSB + WS_P), (const float*)(WSB + WS_ER), (float*)(WSB + WS_SSQO), G, bid);
    grid.sync();
    if constexpr (PH_MASK & 32) hg_norm_pass(IG, (const float*)(WSB + WS_SSQO), karg_in(8), G, bid);
    if constexpr (PH_MASK & 64) { EpiPlain<1536, 128> E{QF}; run_gemm(lds, cqg, (const bf16_t*)(WSB + WS_WQ), T, 1536, 384, E, G, bid); }
    if constexpr (PH_MASK & 64) { EpiPlain<1536, 192> E{KF}; run_gemm(lds, ckvg, (const bf16_t*)(WSB + WS_WKV), T, 1024, 256, E, G, bid); }
    if constexpr (PH_MASK & 128) { EpiPlain<T, 128> E{R3}; run_gemm(lds, (const bf16_t*)(WSB + WS_WKV) + (size_t)1024 * 256, ckvg, 1024, T, 256, E, G, bid); }
    grid.sync();
    if constexpr (PH_MASK & 256) mla_finalize(QF, KF, kpe, (const int*)karg_in(1), karg_in(14), karg_in(15), G, bid);
    grid.sync();
    if constexpr (PH_MASK & 512) attn_phase<0>(lds, QF, KF, R3, IG, (const int*)karg_in(1), karg_in(14), G, bid);
    grid.sync();
    if constexpr (PH_MASK & 1024) { EpiGate E{QF, ssq_mix, karg_in(18)}; run_gemm(lds, HGM, (const bf16_t*)(WSB + WS_WMG), T, 2048, 1024, E, G, bid); }
    grid.sync();
    if constexpr (PH_MASK & 2048) { EpiBranch<false> E{QF, 1024, cqg, nullptr}; run_gemm(lds, IG, (const bf16_t*)(WSB + WS_WBR), T, 1024, 1024, E, G, bid, 2048, 2048); }
    if constexpr (PH_MASK & 2048) { EpiBranch<true> E{QF, 0, cqg, R3}; run_gemm(lds, IG + 1024, (const bf16_t*)(WSB + WS_WBR) + 1024, T, 1024, 1024, E, G, bid, 2048, 2048); }
    grid.sync();
    if constexpr (PH_MASK & 4096) { EpiRes<bf16_t, bf16_t, 2> E{HB, HB, KF, karg_in(20), ssq2}; run_gemm(lds, R3, (const bf16_t*)(WSB + WS_WOUT), T, 1024, 1024, E, G, bid); }
    grid.sync();
    if constexpr (PH_MASK & 8192) { EpiSwiglu E{HID, ssq2}; run_gemm(lds, KF, (const bf16_t*)(WSB + WS_W2IN), T, 5632, 1024, E, G, bid); }
    grid.sync();
    if constexpr (PH_MASK & 16384) { EpiRes<bf16_t, bf16_t, 1> E{HB, H3, nullptr, nullptr, nullptr}; run_gemm(lds, HID, (const bf16_t*)(WSB + WS_W2OUT), T, 1024, DFF, E, G, bid); }
    grid.sync();
    { FRESH_LANE_IDS;
    for (int m = gw; m < T; m += NGW) {
        const u32x2* xr = (const u32x2*)(H3 + (size_t)m * DM) + lane; f32x4* orow = (f32x4*)(OUTP + (size_t)m * DM) + lane; const f32x4* gr = (const f32x4*)karg_in(23) + lane;
        f32x4 v[4]; float s = 0.f;
#pragma unroll
        for (int j = 0; j < 4; ++j) { const u32x2 a = xr[64 * j];
            v[j] = (f32x4){__uint_as_float(a.x << 16), __uint_as_float(a.x & 0xffff0000u), __uint_as_float(a.y << 16), __uint_as_float(a.y & 0xffff0000u)};
            s += (v[j].x * v[j].x + v[j].y * v[j].y) + (v[j].z * v[j].z + v[j].w * v[j].w); }
        const float r = rsqrtf(wave_sum(s) * (1.0f / DM) + EPS);
#pragma unroll
        for (int j = 0; j < 4; ++j) orow[64 * j] = v[j] * r * gr[64 * j];
    } }
#if defined(PROBE_PHASE)
    grid.sync();
#if PROBE_PHASE == 1
    attn_phase<0>(lds, QF, KF, R3, IG, (const int*)karg_in(1), karg_in(14), G, bid);
#elif PROBE_PHASE == 10
    attn_phase<1>(lds, QF, KF, R3, IG, (const int*)karg_in(1), karg_in(14), G, bid);
#elif PROBE_PHASE == 12
    attn_phase<2>(lds, QF, KF, R3, IG, (const int*)karg_in(1), karg_in(14), G, bid);
#elif PROBE_PHASE == 13
    attn_phase<3>(lds, QF, KF, R3, IG, (const int*)karg_in(1), karg_in(14), G, bid);
#elif PROBE_PHASE == 14
    attn_phase<4>(lds, QF, KF, R3, IG, (const int*)karg_in(1), karg_in(14), G, bid);
#elif PROBE_PHASE == 2
    hg_recur(lds, QF, IG, (const bf16_t*)(WSB + WS_P), (const float*)(WSB + WS_ER), (float*)(WSB + WS_SSQO), G, bid);
#elif PROBE_PHASE == 3
    hg_prepass(lds, QF, karg_in(7), (bf16_t*)(WSB + WS_P), (float*)(WSB + WS_ER), G, bid);
#elif PROBE_PHASE == 4
    prologue(lds, G, bid);
#elif PROBE_PHASE == 6
    { EpiSwiglu E{HID, ssq2}; run_gemm(lds, KF, (const bf16_t*)(WSB + WS_W2IN), T, 5632, 1024, E, G, bid); }
#elif PROBE_PHASE == 7
    { EpiRes<bf16_t, float, 1> E{HB, (float*)(WSB + 600 * MiB), nullptr, nullptr, nullptr}; run_gemm(lds, HID, (const bf16_t*)(WSB + WS_W2OUT), T, 1024, DFF, E, G, bid); }
#elif PROBE_PHASE == 8
    { EpiIn E{QF, IG, cqg, ckvg, kpe, ssq_mix, ssq_cq, ssq_ckv, karg_in(10), karg_in(12)}; run_gemm(lds, R3, (const bf16_t*)(WSB + WS_WIN), T, NIN, 1024, E, G, bid); }
#elif PROBE_PHASE == 9
    { EpiGate E{QF, ssq_mix, karg_in(18)}; run_gemm(lds, R3, (const bf16_t*)(WSB + WS_WMG), T, 2048, 1024, E, G, bid); }
#elif PROBE_PHASE == 11
    { EpiPlain<1536, 128> E{QF}; run_gemm(lds, cqg, (const bf16_t*)(WSB + WS_WQ), T, 1536, 384, E, G, bid); }
    { EpiPlain<1536, 192> E{KF}; run_gemm(lds, ckvg, (const bf16_t*)(WSB + WS_WKV), T, 1024, 256, E, G, bid); }
    { EpiPlain<T, 128> E{R3}; run_gemm(lds, (const bf16_t*)(WSB + WS_WKV) + (size_t)1024 * 256, ckvg, 1024, T, 256, E, G, bid); }
#elif PROBE_PHASE == 5
    mla_finalize(QF, KF, kpe, (const int*)karg_in(1), karg_in(14), karg_in(15), G, bid);
#endif
#endif
}

extern "C" void kernel_launch(void* const* d_in, const int* in_sizes, int n_in, void* d_out, int out_size, void* d_ws, size_t ws_size, hipStream_t stream) {
    static int grid_blocks = 0;
    if (grid_blocks == 0) {
        if (n_in != 24 || out_size != T * DM || ws_size < WS_NEED) { fprintf(stderr, "kernel_launch: unexpected shapes (n_in %d out %d ws %zu)\n", n_in, out_size, ws_size); grid_blocks = -1; return; }
        int dev = 0, cus = 0, per_cu = 0;
        hipGetDevice(&dev);
        hipDeviceGetAttribute(&cus, hipDeviceAttributeMultiprocessorCount, dev);
        if (hipFuncSetAttribute((const void*)fwd_megakernel, hipFuncAttributeMaxDynamicSharedMemorySize, LDS_BYTES) != hipSuccess) { fprintf(stderr, "kernel_launch: hipFuncSetAttribute failed\n"); grid_blocks = -1; return; }
        if (hipOccupancyMaxActiveBlocksPerMultiprocessor(&per_cu, (const void*)fwd_megakernel, 512, LDS_BYTES) != hipSuccess || per_cu < 1) { fprintf(stderr, "kernel_launch: occupancy query gave %d\n", per_cu); per_cu = 1; (void)hipGetLastError(); }
        grid_blocks = cus * per_cu;
    }
    if (grid_blocks < 0) return;
    Params p{};
    for (int i = 0; i < 24; ++i) p.in[i] = (const float*)d_in[i];
    p.out = (float*)d_out; p.ws = (unsigned char*)d_ws;
    void* args[] = {&p};
    hipError_t e = hipLaunchCooperativeKernel((const void*)fwd_megakernel, dim3(grid_blocks), dim3(512), args, LDS_BYTES, stream);
    if (e != hipSuccess) fprintf(stderr, "cooperative launch failed: %s (grid %d)\n", hipGetErrorString(e), grid_blocks);
}
```

```cpp
#include <hip/hip_runtime.h>
#include <hip/hip_cooperative_groups.h>
#include <cstdio>
#include <cstdint>
namespace cg = cooperative_groups;
namespace pg8 {
#define PG8_LAS __attribute__((address_space(3)))
typedef unsigned short bf16_t;
typedef short bf16x8 __attribute__((ext_vector_type(8)));
typedef float f32x4 __attribute__((ext_vector_type(4)));
typedef unsigned u32x4 __attribute__((ext_vector_type(4)));
constexpr int BM = 256, BK = 64, HALF = 128, HTB = HALF * BK * 2  , STAGE_BYTES = 8 * HTB, NXCD = 8, WGM = 8;

__host__ __device__ __forceinline__ int lds_byte(int r, int c) { const int st = (r >> 4) * 2 + (c >> 5), rr = r & 15, cc = c & 31, ob = rr * 64 + cc * 2; return st * 1024 + (ob ^ (((ob >> 9) & 1) << 5)); }
__host__ __device__ __forceinline__ void stage_rc(int b, int& R, int& C) { const int st = b / 1024, sb = b % 1024, swz = sb ^ (((sb >> 9) & 1) << 5); R = (st >> 1) * 16 + swz / 64; C = (st & 1) * 32 + (swz % 64) / 2; }
__host__ __device__ __forceinline__ int perm32(int rho) { const int n = rho >> 4, i = rho & 15; return 8 * (i >> 2) + 4 * n + (i & 3); }

struct Unit { int pm, pn; };
struct Gemm { const bf16_t* A; const bf16_t* Bt; int M, N, K, lda, ldb; };

struct StaticOrder {
    int nM, nN, nwg, G, c;
    __host__ __device__ void init(int M, int N, int G_, int c_) { nM = M / BM; nN = N / BM; nwg = nM * nN; G = G_; c = c_; }
    __host__ __device__ bool next(int i, Unit& u) const {
        const long L = (long)i * G + c; if (L >= nwg) return false;
        int wgid = (int)L; { const int q = nwg / NXCD, r = nwg % NXCD, xcd = wgid % NXCD, off = wgid / NXCD; wgid = (xcd < r ? xcd * (q + 1) : r * (q + 1) + (xcd - r) * q) + off; }
        const int nig = WGM * nN, gid = wgid / nig, fm = gid * WGM, gsz = (nM - fm) < WGM ? (nM - fm) : WGM;
        u.pm = fm + ((wgid % nig) % gsz); u.pn = (wgid % nig) / gsz; return true;
    }
    __device__ __forceinline__ void a_ready(const Unit&) const {}
    __device__ __forceinline__ void done(const Unit&) const {}
};

__device__ __forceinline__ unsigned cvt_pk_bf16(float lo, float hi) { unsigned r; asm volatile("v_cvt_pk_bf16_f32 %0, %1, %2" : "=v"(r) : "v"(lo), "v"(hi)); return r; }
typedef float f32x2 __attribute__((ext_vector_type(2)));
template <class Epi, class Sched, bool ALIGN_EPI = false, bool SP2 = false>
__device__ __forceinline__ void gemm_phase(PG8_LAS unsigned char* lds, const Gemm g, const Sched& S, const Epi& E) {
    int tid_l = threadIdx.x; asm volatile("" : "+v"(tid_l));
    const int tid = tid_l, wid = __builtin_amdgcn_readfirstlane(tid >> 6), lane = tid & 63, wr = wid >> 2, wc = wid & 3, fr = lane & 15, fq = lane >> 4;
    int Kopaque = g.K; asm volatile("" : "+s"(Kopaque));
    const int K = Kopaque, nt = K / BK;
    unsigned voffA[2], voffB[2];
#pragma unroll
    for (int i = 0; i < 2; ++i) { int R, C; stage_rc(tid * 16 + i * 8192, R, C); const int Rb = Epi::PERM ? ((R & ~31) + perm32(R & 31)) : R;
        voffA[i] = (unsigned)(R * g.lda + C) * 2u; voffB[i] = (unsigned)(Rb * g.ldb + C) * 2u; }
    const size_t kstep = (size_t)(BK * 2);
    const size_t hstepA = (size_t)HALF * g.lda * 2, hstepB = (size_t)HALF * g.ldb * 2;
    const size_t tstepA = 2 * hstepA, tstepB = 2 * hstepB;
    const unsigned ldsw = (unsigned)wid * 1024u;
    const int aoff = lds_byte(wr * 64 + fr, fq * 8), boff = lds_byte(wc * 32 + fr, fq * 8);
#define PG8_SA(b, h) (((b) * 2 + (h)) * HTB)
#define PG8_SB(b, h) ((4 + (b) * 2 + (h)) * HTB)
#define PG8_STAGE(bufoff, gbase, voff) do { _Pragma("unroll") for (int _i = 0; _i < 2; ++_i) \
        __builtin_amdgcn_global_load_lds((const unsigned*)((const char*)(gbase) + (voff)[_i]), (PG8_LAS unsigned*)(lds + (bufoff) + ldsw + _i * 8192), 16, 0, 0); } while (0)
#define PG8_LDA(dst, b, h) do { _Pragma("unroll") for (int m = 0; m < 4; ++m) _Pragma("unroll") for (int k = 0; k < 2; ++k) dst[m][k] = *(const PG8_LAS bf16x8*)(lds + PG8_SA(b, h) + aoff + m * 2048 + k * 1024); } while (0)
#define PG8_LDB(dst, b, h) do { _Pragma("unroll") for (int n = 0; n < 2; ++n) _Pragma("unroll") for (int k = 0; k < 2; ++k) dst[n][k] = *(const PG8_LAS bf16x8*)(lds + PG8_SB(b, h) + boff + n * 2048 + k * 1024); } while (0)
#define PG8_MMA(ai, bj, At, Bt) do { __builtin_amdgcn_s_setprio(1); _Pragma("unroll") for (int m = 0; m < 4; ++m) _Pragma("unroll") for (int n = 0; n < 2; ++n) _Pragma("unroll") for (int k = 0; k < 2; ++k) \
        acc[ai][bj][m][n] = __builtin_amdgcn_mfma_f32_16x16x32_bf16(Bt[n][k], At[m][k], acc[ai][bj][m][n], 0, 0, 0); __builtin_amdgcn_s_setprio(0); } while (0)
#define PG8_WAIT_V(n) asm volatile("s_waitcnt vmcnt(" #n ")" ::: "memory")
#define PG8_WAIT_L(n) asm volatile("s_waitcnt lgkmcnt(" #n ")" ::: "memory")
#define PG8_BAR __builtin_amdgcn_s_barrier()
#define PG8_SCHED __builtin_amdgcn_sched_barrier(0)
    Unit cur, nxt; int ui = 0;
    if (!S.next(0, cur)) return;
    f32x4 acc[2][2][4][2];
#pragma unroll
    for (int a = 0; a < 2; ++a)
#pragma unroll
        for (int b = 0; b < 2; ++b)
#pragma unroll
            for (int m = 0; m < 4; ++m)
#pragma unroll
                for (int n = 0; n < 2; ++n) acc[a][b][m][n] = (f32x4){0.f, 0.f, 0.f, 0.f};
    bf16x8 At[4][2], B0[2][2], B1[2][2];
    const char* cA = (const char*)g.A + (size_t)cur.pm * tstepA; const char* cB = (const char*)g.Bt + (size_t)cur.pn * tstepB;
    S.a_ready(cur);
    if constexpr (SP2) {
        PG8_STAGE(PG8_SB(0, 0), cB, voffB); PG8_STAGE(PG8_SB(0, 1), cB + hstepB, voffB); PG8_STAGE(PG8_SA(0, 0), cA, voffA); PG8_STAGE(PG8_SA(0, 1), cA + hstepA, voffA);
        if (wr == 1) PG8_BAR;
        PG8_WAIT_V(2); PG8_BAR;
        PG8_STAGE(PG8_SB(1, 0), cB + kstep, voffB); PG8_STAGE(PG8_SA(1, 0), cA + kstep, voffA); PG8_STAGE(PG8_SB(1, 1), cB + hstepB + kstep, voffB);
        PG8_WAIT_V(6); PG8_BAR;
    } else {
        PG8_STAGE(PG8_SB(0, 0), cB, voffB); PG8_STAGE(PG8_SA(0, 0), cA, voffA); PG8_STAGE(PG8_SB(0, 1), cB + hstepB, voffB); PG8_STAGE(PG8_SA(0, 1), cA + hstepA, voffA);
        if (wr == 1) PG8_BAR;
        PG8_WAIT_V(4); PG8_BAR;
        PG8_STAGE(PG8_SB(1, 0), cB + kstep, voffB); PG8_STAGE(PG8_SA(1, 0), cA + kstep, voffA); PG8_STAGE(PG8_SB(1, 1), cB + hstepB + kstep, voffB);
        PG8_WAIT_V(6); PG8_BAR;
    }
    for (;;) {
        const bool has_next = S.next(ui + 1, nxt);
        const char* nA = has_next ? (const char*)g.A + (size_t)nxt.pm * tstepA : cA; const char* nB = has_next ? (const char*)g.Bt + (size_t)nxt.pn * tstepB : cB;
        for (int t = 0; t < nt; t += 2) {
            if constexpr (Epi::MID) { if (t == (nt >> 1)) E.mid(acc, cur, wr, wc, fr, fq); }
            const bool last = (t == nt - 2);
            const char* a1 = cA + (size_t)(t + 1) * kstep;
            const char* a2 = last ? nA : cA + (size_t)(t + 2) * kstep; const char* b2 = last ? nB : cB + (size_t)(t + 2) * kstep;
            const char* a3 = a2 + kstep; const char* b3 = b2 + kstep;
            if (last && has_next) S.a_ready(nxt);
            if constexpr (SP2) {
            PG8_LDB(B0, 0, 0); PG8_LDB(B1, 0, 1); PG8_SCHED; PG8_LDA(At, 0, 0); PG8_STAGE(PG8_SA(1, 1), a1 + hstepA, voffA);
            PG8_WAIT_V(8); PG8_WAIT_L(0); PG8_BAR; PG8_MMA(0, 0, At, B0); PG8_MMA(0, 1, At, B1); PG8_BAR; PG8_SCHED;
            PG8_LDA(At, 0, 1); PG8_STAGE(PG8_SB(0, 0), b2, voffB); PG8_STAGE(PG8_SB(0, 1), b2 + hstepB, voffB); PG8_STAGE(PG8_SA(0, 0), a2, voffA);
            PG8_WAIT_V(8); PG8_WAIT_L(0); PG8_BAR; PG8_MMA(1, 0, At, B0); PG8_MMA(1, 1, At, B1); PG8_BAR; PG8_SCHED;
            PG8_LDB(B0, 1, 0); PG8_LDB(B1, 1, 1); PG8_SCHED; PG8_LDA(At, 1, 0); PG8_STAGE(PG8_SA(0, 1), a2 + hstepA, voffA);
            PG8_WAIT_V(8); PG8_WAIT_L(0); PG8_BAR; PG8_MMA(0, 0, At, B0); PG8_MMA(0, 1, At, B1); PG8_BAR; PG8_SCHED;
            PG8_LDA(At, 1, 1); PG8_STAGE(PG8_SB(1, 0), b3, voffB); PG8_STAGE(PG8_SB(1, 1), b3 + hstepB, voffB); PG8_STAGE(PG8_SA(1, 0), a3, voffA);
            PG8_WAIT_V(8); PG8_WAIT_L(0); PG8_BAR; PG8_MMA(1, 0, At, B0); PG8_MMA(1, 1, At, B1); PG8_BAR; PG8_SCHED;
            } else {
            PG8_LDB(B0, 0, 0); PG8_SCHED; PG8_LDA(At, 0, 0); PG8_STAGE(PG8_SA(1, 1), a1 + hstepA, voffA);
            PG8_WAIT_L(8); PG8_BAR; PG8_WAIT_L(0); PG8_MMA(0, 0, At, B0); PG8_BAR; PG8_SCHED;
            PG8_LDB(B1, 0, 1); PG8_STAGE(PG8_SB(0, 0), b2, voffB);
            PG8_BAR; PG8_WAIT_L(0); PG8_MMA(0, 1, At, B1); PG8_BAR;
            PG8_LDA(At, 0, 1); PG8_STAGE(PG8_SA(0, 0), a2, voffA);
            PG8_BAR; PG8_WAIT_L(0); PG8_MMA(1, 0, At, B0); PG8_BAR; PG8_SCHED;
            PG8_STAGE(PG8_SB(0, 1), b2 + hstepB, voffB);
            PG8_WAIT_V(6); PG8_BAR; PG8_MMA(1, 1, At, B1); PG8_BAR;
            PG8_LDB(B0, 1, 0); PG8_SCHED; PG8_LDA(At, 1, 0); PG8_STAGE(PG8_SA(0, 1), a2 + hstepA, voffA);
            PG8_WAIT_L(8); PG8_BAR; PG8_WAIT_L(0); PG8_MMA(0, 0, At, B0); PG8_BAR; PG8_SCHED;
            PG8_LDB(B1, 1, 1); PG8_STAGE(PG8_SB(1, 0), b3, voffB);
            PG8_BAR; PG8_WAIT_L(0); PG8_MMA(0, 1, At, B1); PG8_BAR;
            PG8_LDA(At, 1, 1); PG8_STAGE(PG8_SA(1, 0), a3, voffA);
            PG8_BAR; PG8_WAIT_L(0); PG8_MMA(1, 0, At, B0); PG8_BAR; PG8_SCHED;
            PG8_STAGE(PG8_SB(1, 1), b3 + hstepB, voffB);
            PG8_WAIT_V(6); PG8_BAR; PG8_MMA(1, 1, At, B1); PG8_BAR;
            }
        }
        if constexpr (ALIGN_EPI) { if (wr == 0) PG8_BAR; }
        if constexpr (!Epi::AFTER_DRAIN) { E(acc, cur, wr, wc, fr, fq); S.done(cur); }
        if (!has_next) break;
#pragma unroll
        for (int a = 0; a < 2; ++a)
#pragma unroll
            for (int b = 0; b < 2; ++b)
#pragma unroll
                for (int m = 0; m < 4; ++m)
#pragma unroll
                    for (int n = 0; n < 2; ++n) acc[a][b][m][n] = (f32x4){0.f, 0.f, 0.f, 0.f};
        cur = nxt; cA = nA; cB = nB; ++ui;
        if constexpr (ALIGN_EPI) { if (wr == 1) PG8_BAR; }
    }
    PG8_WAIT_V(0);
    if constexpr (!ALIGN_EPI) { if (wr == 0) PG8_BAR; }
    PG8_BAR;
    if constexpr (Epi::AFTER_DRAIN) { E.fused(acc, cur, wr, wc, fr, fq, lds, wid, lane); S.done(cur); }
#undef PG8_SA
#undef PG8_SB
#undef PG8_STAGE
#undef PG8_LDA
#undef PG8_LDB
#undef PG8_MMA
#undef PG8_WAIT_V
#undef PG8_WAIT_L
#undef PG8_BAR
#undef PG8_SCHED
}
}

constexpr int BATCH = 8, SEQ = 8192, DM = 1024, T = BATCH * SEQ, DFF = 2816;
constexpr int NIN = 4864;
constexpr float EPS = 1e-6f;
constexpr float QSCALE = 0.07216878364870322f * 1.4426950408889634f;

#define LAS __attribute__((address_space(3)))
typedef unsigned short bf16_t;
typedef short bf16x8 __attribute__((ext_vector_type(8)));
typedef short s16x4 __attribute__((ext_vector_type(4)));
typedef float f32x4 __attribute__((ext_vector_type(4)));
typedef float f32x16 __attribute__((ext_vector_type(16)));
typedef unsigned u32x4 __attribute__((ext_vector_type(4)));
typedef unsigned u32x2 __attribute__((ext_vector_type(2)));

__device__ __forceinline__ float bf2f(bf16_t v) { return __uint_as_float(((unsigned)v) << 16); }
__device__ __forceinline__ unsigned f2bf(float f) { unsigned u = __float_as_uint(f); return (u + 0x7fffu + ((u >> 16) & 1u)) >> 16; }
__device__ __forceinline__ unsigned pk2(float lo, float hi) { return pg8::cvt_pk_bf16(lo, hi); }
__device__ __forceinline__ float fast_rcp(float x) { return __builtin_amdgcn_rcpf(x); }
__device__ __forceinline__ float silu_f(float x) { return x * fast_rcp(1.0f + __expf(-x)); }
__device__ __forceinline__ float sigmoid_f(float x) { return fast_rcp(1.0f + __expf(-x)); }
__device__ __forceinline__ float wave_sum(float v) {
#pragma unroll
    for (int o = 1; o < 64; o <<= 1) v += __shfl_xor(v, o);
    return v;
}

#define LDS_BARRIER() do { asm volatile("s_waitcnt lgkmcnt(0)" ::: "memory"); __builtin_amdgcn_s_barrier(); asm volatile("" ::: "memory"); } while (0)
constexpr size_t MiB = 1u << 20;
constexpr size_t WS_SSQ_MIX = 0, WS_SSQ_CQ = 256 * 1024, WS_SSQ_CKV = 512 * 1024, WS_SSQ2 = 768 * 1024;
constexpr size_t WS_W1IN = 2 * MiB;
constexpr size_t WS_W1OUT = WS_W1IN + (size_t)5632 * 1024 * 2;
constexpr size_t WS_WIN = WS_W1OUT + (size_t)1024 * 2816 * 2;
constexpr size_t WS_WMG = WS_WIN + (size_t)NIN * 1024 * 2;
constexpr size_t WS_WQ = WS_WMG + (size_t)2048 * 1024 * 2;
constexpr size_t WS_WKV = WS_WQ + (size_t)1536 * 384 * 2;
constexpr size_t WS_WBR = WS_WKV + (size_t)2048 * 256 * 2;
constexpr size_t WS_WOUT = WS_WBR + (size_t)1024 * 2048 * 2;
constexpr size_t WS_W2IN = WS_WOUT + (size_t)1024 * 1024 * 2;
constexpr size_t WS_W2OUT = WS_W2IN + (size_t)5632 * 1024 * 2;
constexpr size_t WS_WEND = WS_W2OUT + (size_t)1024 * 2816 * 2;
static_assert(WS_WEND <= 60 * MiB, "weights fit");
constexpr size_t WS_SSQO = 60 * MiB;
constexpr size_t WS_R3 = 64 * MiB;
constexpr size_t WS_P = WS_R3, WS_ER = WS_R3 + 32 * MiB, WS_DR = WS_R3 + 40 * MiB;
constexpr size_t WS_IG = 192 * MiB;
constexpr size_t WS_QF = 448 * MiB;
constexpr size_t WS_CQG = 704 * MiB;
constexpr size_t WS_CKVG = 752 * MiB;
constexpr size_t WS_KPE = 784 * MiB;
constexpr size_t WS_KF = 792 * MiB;
constexpr size_t WS_HID = 192 * MiB;
constexpr size_t WS_NEED = 984 * MiB;

constexpr int LDS_BYTES = 147456;

struct Params {
    const float* in[24];
    float* out;
    unsigned char* ws;
};

typedef const f32x4 (&AccRef)[2][2][4][2];

struct EpiSwiglu {
    static constexpr bool PERM = true, AFTER_DRAIN = false, MID = false;
    bf16_t* O; const float* ssq;
    __device__ __forceinline__ void mid(f32x4 (&)[2][2][4][2], const pg8::Unit&, int, int, int, int) const {}
    __device__ __forceinline__ void operator()(AccRef acc, const pg8::Unit& u, int wr, int wc, int fr, int fq) const {
        const int col = u.pn * 128 + wc * 32 + 8 * fq;
#pragma unroll
        for (int ai = 0; ai < 2; ++ai)
#pragma unroll
            for (int m = 0; m < 4; ++m) {
                const int row = u.pm * 256 + ai * 128 + wr * 64 + m * 16 + fr;
                const float s = ssq ? rsqrtf(ssq[row] * (1.0f / 1024.0f) + EPS) : 1.0f;
                float h[8];
#pragma unroll
                for (int n = 0; n < 2; ++n)
#pragma unroll
                    for (int j = 0; j < 4; ++j) { const float g = acc[ai][0][m][n][j] * s, up = acc[ai][1][m][n][j] * s; h[n * 4 + j] = silu_f(g) * up; }
                u32x4 w; w.x = pk2(h[0], h[1]); w.y = pk2(h[2], h[3]); w.z = pk2(h[4], h[5]); w.w = pk2(h[6], h[7]);
                *(u32x4*)(O + (size_t)row * DFF + col) = w;
            }
    }
};

template <class TB, class TO, int COEF2> struct EpiRes {
    static constexpr bool PERM = true, AFTER_DRAIN = false, MID = false;
    static constexpr bool BASE_BF16 = sizeof(TB) == 2, OUT_BF16 = sizeof(TO) == 2;
    static constexpr float coef = 0.5f * COEF2;
    const TB* base; TO* out; bf16_t* og; const float* gain; float* ssq;
    __device__ __forceinline__ void mid(f32x4 (&)[2][2][4][2], const pg8::Unit&, int, int, int, int) const {}
    __device__ __forceinline__ void operator()(AccRef acc, const pg8::Unit& u, int wr, int wc, int fr, int fq) const {
        const int col0 = u.pn * 256 + wc * 32 + 8 * fq;
        f32x4 gv[2][2];
#pragma unroll
        for (int bj = 0; bj < 2; ++bj)
#pragma unroll
            for (int n = 0; n < 2; ++n) gv[bj][n] = og ? *(const f32x4*)(gain + col0 + bj * 128 + 4 * n) : (f32x4){0.f, 0.f, 0.f, 0.f};
#pragma unroll
        for (int ai = 0; ai < 2; ++ai)
#pragma unroll
            for (int m = 0; m < 4; ++m) {
                const int row = u.pm * 256 + ai * 128 + wr * 64 + m * 16 + fr;
                float sq = 0.f;
#pragma unroll
                for (int bj = 0; bj < 2; ++bj) {
                    const size_t off = (size_t)row * DM + col0 + bj * 128;
                    f32x4 b0, b1;
                    if (BASE_BF16) { const u32x4 bb = *(const u32x4*)((const bf16_t*)base + off);
                        b0 = (f32x4){__uint_as_float(bb.x << 16), __uint_as_float(bb.x & 0xffff0000u), __uint_as_float(bb.y << 16), __uint_as_float(bb.y & 0xffff0000u)};
                        b1 = (f32x4){__uint_as_float(bb.z << 16), __uint_as_float(bb.z & 0xffff0000u), __uint_as_float(bb.w << 16), __uint_as_float(bb.w & 0xffff0000u)}; }
                    else { b0 = *(const f32x4*)((const float*)base + off); b1 = *(const f32x4*)((const float*)base + off + 4); }
                    const f32x4 o0 = b0 + acc[ai][bj][m][0] * coef, o1 = b1 + acc[ai][bj][m][1] * coef;
                    if (OUT_BF16) { u32x4 w; w.x = pk2(o0[0], o0[1]); w.y = pk2(o0[2], o0[3]); w.z = pk2(o1[0], o1[1]); w.w = pk2(o1[2], o1[3]); *(u32x4*)((bf16_t*)out + off) = w; }
                    else { *(f32x4*)((float*)out + off) = o0; *(f32x4*)((float*)out + off + 4) = o1; }
                    sq += (o0[0] * o0[0] + o0[1] * o0[1]) + (o0[2] * o0[2] + o0[3] * o0[3]) + (o1[0] * o1[0] + o1[1] * o1[1]) + (o1[2] * o1[2] + o1[3] * o1[3]);
                    if (og) { const f32x4 y0 = o0 * gv[bj][0], y1 = o1 * gv[bj][1];
                        u32x4 w; w.x = pk2(y0[0], y0[1]); w.y = pk2(y0[2], y0[3]); w.z = pk2(y1[0], y1[1]); w.w = pk2(y1[2], y1[3]);
                        *(u32x4*)(og + off) = w; }
                }
                if (ssq) { sq += __shfl_xor(sq, 16); sq += __shfl_xor(sq, 32); if (fq == 0) atomicAdd(ssq + row, sq); }
            }
    }
};

struct EpiIn {
    static constexpr bool PERM = true, AFTER_DRAIN = false, MID = false;
    bf16_t *QF, *IG, *cqg, *ckvg, *kpe; const float* ssq_mix; float *ssq_cq, *ssq_ckv; const float *gq, *gkv;
    __device__ __forceinline__ void mid(f32x4 (&)[2][2][4][2], const pg8::Unit&, int, int, int, int) const {}
    __device__ __forceinline__ void operator()(AccRef acc, const pg8::Unit& u, int wr, int wc, int fr, int fq) const {
        float sr[2][4];
#pragma unroll
        for (int ai = 0; ai < 2; ++ai)
#pragma unroll
            for (int m = 0; m < 4; ++m) sr[ai][m] = rsqrtf(ssq_mix[u.pm * 256 + ai * 128 + wr * 64 + m * 16 + fr] * (1.0f / 1024.0f) + EPS);
#pragma unroll
        for (int bj = 0; bj < 2; ++bj) {
            const int c0 = u.pn * 256 + bj * 128, cc = c0 + wc * 32 + 8 * fq;
            bf16_t* dst; int ld; const float* gain = nullptr; float* ssq = nullptr;
            if (c0 < 2048) { dst = QF + cc; ld = 2048; }
            else if (c0 < 4096) { dst = IG + (cc - 2048); ld = 2048; }
            else if (c0 < 4480) { dst = cqg + (cc - 4096); ld = 384; gain = gq + (cc - 4096); ssq = ssq_cq; }
            else if (c0 < 4736) { dst = ckvg + (cc - 4480); ld = 256; gain = gkv + (cc - 4480); ssq = ssq_ckv; }
            else { if (wc >= 2) continue; dst = kpe + (cc - 4736); ld = 64; }
            f32x4 g0 = (f32x4){1.f, 1.f, 1.f, 1.f}, g1 = g0;
            if (gain) { g0 = *(const f32x4*)gain; g1 = *(const f32x4*)(gain + 4); }
#pragma unroll
            for (int ai = 0; ai < 2; ++ai)
#pragma unroll
                for (int m = 0; m < 4; ++m) {
                    const int row = u.pm * 256 + ai * 128 + wr * 64 + m * 16 + fr;
                    const f32x4 v0 = acc[ai][bj][m][0] * sr[ai][m], v1 = acc[ai][bj][m][1] * sr[ai][m];
                    if (ssq) { float sq = (v0[0] * v0[0] + v0[1] * v0[1]) + (v0[2] * v0[2] + v0[3] * v0[3]) + (v1[0] * v1[0] + v1[1] * v1[1]) + (v1[2] * v1[2] + v1[3] * v1[3]);
                        sq += __shfl_xor(sq, 16); sq += __shfl_xor(sq, 32); if (fq == 0) atomicAdd(ssq + row, sq); }
                    const f32x4 y0 = v0 * g0, y1 = v1 * g1;
                    u32x4 w; w.x = pk2(y0[0], y0[1]); w.y = pk2(y0[2], y0[3]); w.z = pk2(y1[0], y1[1]); w.w = pk2(y1[2], y1[3]);
                    *(u32x4*)(dst + (size_t)row * ld) = w;
                }
        }
    }
};

template <int ldc, int hs> struct EpiPlain {
    static constexpr bool PERM = true, AFTER_DRAIN = false, MID = false;
    bf16_t* O;
    __device__ __forceinline__ void mid(f32x4 (&)[2][2][4][2], const pg8::Unit&, int, int, int, int) const {}
    __device__ __forceinline__ void operator()(AccRef acc, const pg8::Unit& u, int wr, int wc, int fr, int fq) const {
#pragma unroll
        for (int ai = 0; ai < 2; ++ai)
#pragma unroll
            for (int m = 0; m < 4; ++m) {
                const int row = u.pm * 256 + ai * 128 + wr * 64 + m * 16 + fr;
#pragma unroll
                for (int bj = 0; bj < 2; ++bj) {
                    const int col = (u.pn * 2 + bj) * hs + wc * 32 + 8 * fq;
                    const f32x4 y0 = acc[ai][bj][m][0], y1 = acc[ai][bj][m][1];
                    u32x4 w; w.x = pk2(y0[0], y0[1]); w.y = pk2(y0[2], y0[3]); w.z = pk2(y1[0], y1[1]); w.w = pk2(y1[2], y1[3]);
                    *(u32x4*)(O + (size_t)row * ldc + col) = w;
                }
            }
    }
};

struct EpiGate {
    static constexpr bool PERM = true, AFTER_DRAIN = false, MID = false;
    bf16_t* G; const float* ssq_mix; const float* bias;
    __device__ __forceinline__ void mid(f32x4 (&)[2][2][4][2], const pg8::Unit&, int, int, int, int) const {}
    __device__ __forceinline__ void operator()(AccRef acc, const pg8::Unit& u, int wr, int wc, int fr, int fq) const {
        const int col0 = u.pn * 256 + wc * 32 + 8 * fq;
        f32x4 bv[2][2];
#pragma unroll
        for (int bj = 0; bj < 2; ++bj)
#pragma unroll
            for (int n = 0; n < 2; ++n) bv[bj][n] = *(const f32x4*)(bias + col0 + bj * 128 + 4 * n);
#pragma unroll
        for (int ai = 0; ai < 2; ++ai)
#pragma unroll
            for (int m = 0; m < 4; ++m) {
                const int row = u.pm * 256 + ai * 128 + wr * 64 + m * 16 + fr;
                const float s = rsqrtf(ssq_mix[row] * (1.0f / 1024.0f) + EPS);
#pragma unroll
                for (int bj = 0; bj < 2; ++bj) {
                    const f32x4 a0 = acc[ai][bj][m][0] * s + bv[bj][0], a1 = acc[ai][bj][m][1] * s + bv[bj][1];
                    u32x4 w; w.x = pk2(sigmoid_f(a0[0]), sigmoid_f(a0[1])); w.y = pk2(sigmoid_f(a0[2]), sigmoid_f(a0[3]));
                    w.z = pk2(sigmoid_f(a1[0]), sigmoid_f(a1[1])); w.w = pk2(sigmoid_f(a1[2]), sigmoid_f(a1[3]));
                    *(u32x4*)(G + (size_t)row * 2048 + col0 + bj * 128) = w;
                }
            }
    }
};

template <bool SECOND> struct EpiBranch {
    static constexpr bool PERM = true, AFTER_DRAIN = false, MID = false;
    const bf16_t* G; int gcol0; bf16_t* tmp; bf16_t* O;
    __device__ __forceinline__ void mid(f32x4 (&)[2][2][4][2], const pg8::Unit&, int, int, int, int) const {}
    __device__ __forceinline__ void operator()(AccRef acc, const pg8::Unit& u, int wr, int wc, int fr, int fq) const {
        const int col0 = u.pn * 256 + wc * 32 + 8 * fq;
#pragma unroll
        for (int ai = 0; ai < 2; ++ai)
#pragma unroll
            for (int m = 0; m < 4; ++m) {
                const int row = u.pm * 256 + ai * 128 + wr * 64 + m * 16 + fr;
#pragma unroll
                for (int bj = 0; bj < 2; ++bj) {
                    const u32x4 gh = *(const u32x4*)(G + (size_t)row * 2048 + gcol0 + col0 + bj * 128);
                    u32x4 tv = (u32x4){0u, 0u, 0u, 0u};
                    if (SECOND) tv = *(const u32x4*)(tmp + (size_t)row * DM + col0 + bj * 128);
                    float y[8];
#pragma unroll
                    for (int q = 0; q < 4; ++q) {
                        const float h0 = __uint_as_float(gh[q] << 16), h1 = __uint_as_float(gh[q] & 0xffff0000u);
                        const float t0 = __uint_as_float(tv[q] << 16), t1 = __uint_as_float(tv[q] & 0xffff0000u);
                        const int n = q >> 1, j = (q & 1) * 2;
                        y[2 * q] = acc[ai][bj][m][n][j] * h0 + t0; y[2 * q + 1] = acc[ai][bj][m][n][j + 1] * h1 + t1;
                    }
                    u32x4 w; w.x = pk2(y[0], y[1]); w.y = pk2(y[2], y[3]); w.z = pk2(y[4], y[5]); w.w = pk2(y[6], y[7]);
                    *(u32x4*)((SECOND ? O : tmp) + (size_t)row * DM + col0 + bj * 128) = w;
                }
            }
    }
};

template <class Epi, bool ALIGN = true>
__device__ __forceinline__ void run_gemm(LAS unsigned char* lds, const bf16_t* A, const bf16_t* Bt, int M, int N, int K, const Epi& E, int G, int c, int lda = 0, int ldb = 0) {
    pg8::Gemm g{A, Bt, M, N, K, lda ? lda : K, ldb ? ldb : K}; pg8::StaticOrder S; S.init(M, N, G, c);
    pg8::gemm_phase<Epi, pg8::StaticOrder, ALIGN, true>(lds, g, S, E);
}

typedef __attribute__((address_space(4))) const unsigned char* karg_ptr_t;
__device__ __forceinline__ const float* karg_in(int i) { karg_ptr_t kp = (karg_ptr_t)__builtin_amdgcn_kernarg_segment_ptr(); asm volatile("" : "+s"(kp)); return *(const float* __attribute__((address_space(4))) const*)(kp + 8 * i); }
__device__ __forceinline__ float* karg_out() { karg_ptr_t kp = (karg_ptr_t)__builtin_amdgcn_kernarg_segment_ptr(); asm volatile("" : "+s"(kp)); return *(float* __attribute__((address_space(4))) const*)(kp + 8 * 24); }
__device__ __forceinline__ unsigned char* karg_ws() { karg_ptr_t kp = (karg_ptr_t)__builtin_amdgcn_kernarg_segment_ptr(); asm volatile("" : "+s"(kp)); return *(unsigned char* __attribute__((address_space(4))) const*)(kp + 8 * 25); }
__device__ __forceinline__ int tr_map(int mode, int n) {
    if (mode == 0) return n;
    if (mode == 1) { if (n < DFF) return 256 * (n >> 7) + (n & 127); const int n2 = n - DFF; return 256 * (n2 >> 7) + 128 + (n2 & 127); }
    const int h = n >> 8, j = n & 255; return ((j < 128) ? 0 : 1024) + h * 128 + (j & 127);
}
__device__ __forceinline__ void tr_item(const float* W, int K, int N, bf16_t* WT, int ldk, int koff, int mode, LAS float* scr, int item, int lane) {
    const int nblk = N / 32, kb = item / nblk, nb = item % nblk, k0 = 64 * kb, n0 = 32 * nb;
    float wv[32];
#pragma unroll
    for (int i = 0; i < 32; ++i) wv[i] = W[(size_t)(k0 + 2 * i + (lane >> 5)) * N + n0 + (lane & 31)];
#pragma unroll
    for (int i = 0; i < 32; ++i) scr[(2 * i + (lane >> 5)) * 33 + (lane & 31)] = wv[i];
    asm volatile("s_waitcnt lgkmcnt(0)" ::: "memory");
    const int c = lane & 7;
#pragma unroll
    for (int j = 0; j < 4; ++j) { const int n = (lane >> 3) + 8 * j; const LAS float* s = scr + (8 * c) * 33 + n;
        u32x4 o; o.x = f2bf(s[0 * 33]) | (f2bf(s[1 * 33]) << 16); o.y = f2bf(s[2 * 33]) | (f2bf(s[3 * 33]) << 16); o.z = f2bf(s[4 * 33]) | (f2bf(s[5 * 33]) << 16); o.w = f2bf(s[6 * 33]) | (f2bf(s[7 * 33]) << 16);
        *(u32x4*)(WT + (size_t)tr_map(mode, n0 + n) * ldk + koff + k0 + 8 * c) = o; }
    asm volatile("s_waitcnt lgkmcnt(0)" ::: "memory");
}
__device__ __forceinline__ void row_to_bf16(const float* xrow, const float* gain, bf16_t* orow, bool norm, int lane) {
    const f32x4* xr = (const f32x4*)xrow + lane; const f32x4* gr = (const f32x4*)gain + lane;
    f32x4 v[4]; float s = 0.f;
#pragma unroll
    for (int j = 0; j < 4; ++j) { v[j] = xr[64 * j]; s += (v[j].x * v[j].x + v[j].y * v[j].y) + (v[j].z * v[j].z + v[j].w * v[j].w); }
    float r = 1.0f;
    if (norm) r = rsqrtf(wave_sum(s) * (1.0f / DM) + EPS);
    u32x2* o8 = (u32x2*)orow + lane;
#pragma unroll
    for (int j = 0; j < 4; ++j) { const f32x4 g = gr[64 * j]; u32x2 w; w.x = pk2(v[j].x * r * g.x, v[j].y * r * g.y); w.y = pk2(v[j].z * r * g.z, v[j].w * r * g.w); o8[64 * j] = w; }
}

__device__ __forceinline__ void prologue(LAS unsigned char* lds, int G, int bid) {
    int tid_l = threadIdx.x; asm volatile("" : "+v"(tid_l));
    const int tid = tid_l, wave = tid >> 6, lane = tid & 63;
    LAS float* scr = (LAS float*)(lds + wave * 16384);
    const int gw = bid * 8 + wave, NGW = G * 8;
    { float* z = (float*)(karg_ws() + WS_SSQ_MIX); for (int i = bid * 512 + tid; i < 4 * T; i += G * 512) z[i] = 0.f; }
    { float* z = (float*)(karg_ws() + WS_SSQO); for (int i = bid * 512 + tid; i < 8 * T; i += G * 512) z[i] = 0.f; }
    constexpr int I0 = 16 * 176, I1 = 44 * 32, I2 = 16 * 150, I3 = 16 * 64, I4 = 6 * 48, I5 = 4 * 64, I6 = 16 * 32;
    constexpr int NITEMS = 2 * I0 + 2 * I1 + I2 + I3 + I4 + I5 + 3 * I6;
    for (int it = gw; it < NITEMS; it += NGW) {
        int r = it;
        if (r < I0) { tr_item(karg_in(3), 1024, 5632, (bf16_t*)(karg_ws() + WS_W1IN), 1024, 0, 1, scr, r, lane); continue; } r -= I0;
        if (r < I0) { tr_item(karg_in(21), 1024, 5632, (bf16_t*)(karg_ws() + WS_W2IN), 1024, 0, 1, scr, r, lane); continue; } r -= I0;
        if (r < I1) { tr_item(karg_in(4), 2816, 1024, (bf16_t*)(karg_ws() + WS_W1OUT), 2816, 0, 0, scr, r, lane); continue; } r -= I1;
        if (r < I1) { tr_item(karg_in(22), 2816, 1024, (bf16_t*)(karg_ws() + WS_W2OUT), 2816, 0, 0, scr, r, lane); continue; } r -= I1;
        if (r < I2) { tr_item(karg_in(6), 1024, 4800, (bf16_t*)(karg_ws() + WS_WIN), 1024, 0, 0, scr, r, lane); continue; } r -= I2;
        if (r < I3) { tr_item(karg_in(17), 1024, 2048, (bf16_t*)(karg_ws() + WS_WMG), 1024, 0, 0, scr, r, lane); continue; } r -= I3;
        if (r < I4) { tr_item(karg_in(11), 384, 1536, (bf16_t*)(karg_ws() + WS_WQ), 384, 0, 0, scr, r, lane); continue; } r -= I4;
        if (r < I5) { tr_item(karg_in(13), 256, 2048, (bf16_t*)(karg_ws() + WS_WKV), 256, 0, 2, scr, r, lane); continue; } r -= I5;
        if (r < I6) { tr_item(karg_in(16), 1024, 1024, (bf16_t*)(karg_ws() + WS_WBR), 2048, 0, 0, scr, r, lane); continue; } r -= I6;
        if (r < I6) { tr_item(karg_in(9), 1024, 1024, (bf16_t*)(karg_ws() + WS_WBR), 2048, 1024, 0, scr, r, lane); continue; } r -= I6;
        tr_item(karg_in(19), 1024, 1024, (bf16_t*)(karg_ws() + WS_WOUT), 1024, 0, 0, scr, r, lane);
    }
    bf16_t* u1 = (bf16_t*)(karg_ws() + WS_R3);
    for (int m = gw; m < T; m += NGW) row_to_bf16(karg_in(0) + (size_t)m * DM, karg_in(2), u1 + (size_t)m * DM, true, lane);
}

__device__ __forceinline__ void hg_prepass(LAS unsigned char* lds, bf16_t* QF, const float* lbtab, bf16_t* P, float* Dg, int G, int bid) {
    int tid_l = threadIdx.x; asm volatile("" : "+v"(tid_l));
    const int tid = tid_l, wave = tid >> 6, lane = tid & 63, k = tid & 127, tq = tid >> 7, fr = lane & 15, fq = lane >> 4;
    constexpr int PP_BUF = 2048 + 2 * 32 * 136 * 2;
    bf16_t nqr[8], nfr[8];
    if (bid < 16384) { const int h = bid & 7, bc = bid >> 3; const bf16_t* qp = QF + (size_t)(bc * 32 + 8 * tq) * 2048 + 128 * h + k;
#pragma unroll
        for (int j = 0; j < 8; ++j) { nqr[j] = qp[(size_t)j * 2048]; nfr[j] = qp[(size_t)j * 2048 + 1024]; } }
    int it = 0, hprev = -1; float lb = 0.f, omlb = 0.f;
    for (int u = bid; u < 16384; u += G, ++it) {
        LAS float* seg = (LAS float*)(lds + (it & 1) * PP_BUF);
        LAS bf16_t* Qs = (LAS bf16_t*)(lds + (it & 1) * PP_BUF + 2048);
        LAS bf16_t* Ks = Qs + 32 * 136;
        const int h = u & 7, bc = u >> 3, r0 = bc * 32;
        if (h != hprev) {
            const float t0 = lbtab[128 * h + k], t1 = lbtab[1024 + 128 * h + k], mx = fmaxf(t0, t1);
            const float e0 = __expf(t0 - mx), e1 = __expf(t1 - mx);
            lb = e0 / (e0 + e1); omlb = e1 / (e0 + e1); hprev = h;
        }
        bf16_t* qp = QF + (size_t)(r0 + 8 * tq) * 2048 + 128 * h + k;
        float zq[8], zf[8];
#pragma unroll
        for (int j = 0; j < 8; ++j) { zq[j] = bf2f(nqr[j]); zf[j] = bf2f(nfr[j]); }
        { const int un = u + G;
          if (un < 16384) { const int hn = un & 7, bcn = un >> 3; const bf16_t* qn = QF + (size_t)(bcn * 32 + 8 * tq) * 2048 + 128 * hn + k;
#pragma unroll
              for (int j = 0; j < 8; ++j) { nqr[j] = qn[(size_t)j * 2048]; nfr[j] = qn[(size_t)j * 2048 + 1024]; } } }
        float cl[8], kk[8], qs[8]; float run = 0.f;
#pragma unroll
        for (int j = 0; j < 8; ++j) {
            const float z = zf[j], e = __expf(-z), sg = fast_rcp(1.0f + e);
            const float f = lb + omlb * sg;
            kk[j] = omlb * (e < 3.0e38f ? e * sg : 1.0f);
            run += __logf(f); cl[j] = run;
            qs[j] = silu_f(zq[j]);
        }
        seg[tq * 128 + k] = run;
        LDS_BARRIER();
        const float s0 = seg[k], s1 = seg[128 + k], s2 = seg[256 + k], s3 = seg[384 + k];
        const float prefix = (tq > 0 ? s0 : 0.f) + (tq > 1 ? s1 : 0.f) + (tq > 2 ? s2 : 0.f);
        const float cum_r = s0 + s1, cum_e = cum_r + s2 + s3;
        unsigned kb[8];
        const float Erc = __expf(cum_r), Drc = __expf(cum_e - cum_r);
#pragma unroll
        for (int j = 0; j < 8; ++j) {
            const float d = prefix + cl[j] - cum_r;
            const float E1 = __expf(d), E2 = __expf(-d);
            const float qt = qs[j] * E1, kt = kk[j] * E2;
            qp[(size_t)j * 2048] = (bf16_t)f2bf(qt * Erc);
            kb[j] = f2bf(kt * Drc);
            Qs[(8 * tq + j) * 136 + k] = (bf16_t)f2bf(qt); Ks[(8 * tq + j) * 136 + k] = (bf16_t)f2bf(kt);
        }
        { u32x4 w; w.x = kb[0] | (kb[1] << 16); w.y = kb[2] | (kb[3] << 16); w.z = kb[4] | (kb[5] << 16); w.w = kb[6] | (kb[7] << 16);
          *(u32x4*)(QF + (size_t)(r0 + (k >> 2)) * 2048 + 1024 + 128 * h + (k & 3) * 32 + 8 * tq) = w; }
        if (tq == 0) Dg[(size_t)bc * 1024 + 128 * h + k] = __expf(cum_e);
        LDS_BARRIER();
        if (wave < 3) {
            const int tt = wave > 0 ? 1 : 0, ss = wave == 2 ? 1 : 0;
            f32x4 acc = (f32x4){0.f, 0.f, 0.f, 0.f};
#pragma unroll
            for (int k4 = 0; k4 < 4; ++k4) {
                const bf16x8 a = *(const LAS bf16x8*)(Qs + (16 * tt + fr) * 136 + 32 * k4 + 8 * fq);
                const bf16x8 b = *(const LAS bf16x8*)(Ks + (16 * ss + fr) * 136 + 32 * k4 + 8 * fq);
                acc = __builtin_amdgcn_mfma_f32_16x16x32_bf16(a, b, acc, 0, 0, 0);
            }
#pragma unroll
            for (int i = 0; i < 4; ++i) { const int t = 16 * tt + 4 * fq + i, s = 16 * ss + fr;
                const float v = (s <= t) ? acc[i] : 0.f;
                P[(size_t)u * 1024 + t * 32 + s] = (bf16_t)f2bf(v); }
        }
    }
    LDS_BARRIER();
}

constexpr int H3_QP = 272, H3_KP = 80, H3_PP = 80, H3_VP = 80;
constexpr int H3_Q = 0, H3_K = H3_Q + 32 * H3_QP, H3_P = H3_K + 128 * H3_KP, H3_V = H3_P + 32 * H3_PP, H3_D = H3_V + 32 * H3_VP, H3_STAGE = H3_D + 512;
constexpr int H3_O = 2 * H3_STAGE, H3_OBYTES = 4 * 32 * 32 * 4;
static_assert(H3_O + 2 * H3_OBYTES <= 131072 && H3_STAGE % 16 == 0, "recurrence LDS map");
__device__ __forceinline__ void hg_recur(LAS unsigned char* lds, const bf16_t* QF, bf16_t* IG, const bf16_t* P, const float* Dg, float* ssq_o, int G, int bid) {
    int tid_l = threadIdx.x; asm volatile("" : "+v"(tid_l));
    const int tid = tid_l, w = tid >> 6, lane = tid & 63, lv = lane & 15, fq = lane >> 4, vt = w & 1, kq = w >> 1;
    const int srow = tid >> 4, sch = tid & 15;
    for (int u = bid; u < 256; u += G) {
        const int b = u >> 5, h = (u >> 2) & 7, vq = u & 3;
        f32x4 S[2];
        S[0] = (f32x4){0.f, 0.f, 0.f, 0.f}; S[1] = S[0];
#define H3_FLUSH(cc_, stt_) do { \
            { const LAS float* ot = (const LAS float*)(lds + H3_O + (stt_) * H3_OBYTES) + (tid >> 4) * 32 + 2 * (tid & 15); \
              typedef float f32x2v __attribute__((ext_vector_type(2))); \
              const f32x2v p0 = *(const LAS f32x2v*)ot, p1 = *(const LAS f32x2v*)(ot + 1024), p2 = *(const LAS f32x2v*)(ot + 2048), p3 = *(const LAS f32x2v*)(ot + 3072); \
              const float x0 = (p0.x + p1.x) + (p2.x + p3.x), x1 = (p0.y + p1.y) + (p2.y + p3.y); \
              const size_t row = (size_t)(b * 256 + (cc_)) * 32 + (tid >> 4); \
              *(unsigned*)(IG + row * 2048 + 128 * h + 32 * vq + 2 * (tid & 15)) = pk2(x0, x1); \
              float sq = x0 * x0 + x1 * x1; \
              sq += __builtin_bit_cast(float, __builtin_amdgcn_update_dpp(0, __builtin_bit_cast(int, sq), 0x128, 0xf, 0xf, true)); \
              sq += __builtin_bit_cast(float, __builtin_amdgcn_update_dpp(0, __builtin_bit_cast(int, sq), 0x124, 0xf, 0xf, true)); \
              sq += __builtin_bit_cast(float, __builtin_amdgcn_update_dpp(0, __builtin_bit_cast(int, sq), 0x122, 0xf, 0xf, true)); \
              sq += __builtin_bit_cast(float, __builtin_amdgcn_update_dpp(0, __builtin_bit_cast(int, sq), 0x121, 0xf, 0xf, true)); \
              if ((tid & 15) == 0) atomicAdd(ssq_o + row * 8 + h, sq); } } while (0)
        u32x4 rqA, rkA, rxA, rqB, rkB, rxB;
#define H3_GLOAD(X, c_) do { const int bc_ = b * 256 + (c_); const size_t ro_ = (size_t)(bc_ * 32 + srow) * 2048 + 128 * h + 8 * sch; \
            rq##X = *(const u32x4*)(QF + ro_); rk##X = *(const u32x4*)(QF + ro_ + 1024); \
            if (tid < 128) rx##X = *(const u32x4*)(P + ((size_t)bc_ * 8 + h) * 1024 + 8 * tid); \
            else if (tid < 256) rx##X = *(const u32x4*)(IG + (size_t)(bc_ * 32 + ((tid - 128) >> 2)) * 2048 + 128 * h + 32 * vq + 8 * (tid & 3)); \
            else if (tid < 288) rx##X = *(const u32x4*)(Dg + (size_t)bc_ * 1024 + 128 * h + 4 * (tid - 256)); } while (0)
#define H3_LSTORE(X, st_) do { LAS unsigned char* sb_ = lds + (st_) * H3_STAGE; \
            *(LAS u32x4*)(sb_ + H3_Q + srow * H3_QP + sch * 16) = rq##X; \
            *(LAS u32x4*)(sb_ + H3_K + (4 * srow + (sch >> 2)) * H3_KP + (sch & 3) * 16) = rk##X; \
            if (tid < 128) *(LAS u32x4*)(sb_ + H3_P + (tid >> 2) * H3_PP + (tid & 3) * 16) = rx##X; \
            else if (tid < 256) *(LAS u32x4*)(sb_ + H3_V + ((tid - 128) >> 2) * H3_VP + (tid & 3) * 16) = rx##X; \
            else if (tid < 288) *(LAS u32x4*)(sb_ + H3_D + (tid - 256) * 16) = rx##X; } while (0)
        H3_GLOAD(A, 0);
        H3_GLOAD(B, 1);
        H3_LSTORE(A, 0);
        LDS_BARRIER();
        for (int c2 = 0; c2 < 256; c2 += 2) {
#pragma unroll
          for (int par = 0; par < 2; ++par) {
            const int c = c2 + par, st = par;
            if (c + 1 < 256) { if (par == 0) H3_LSTORE(B, 1); else H3_LSTORE(A, 0); }
            if (c + 2 < 256) { if (par == 0) H3_GLOAD(A, c + 2); else H3_GLOAD(B, c + 2); }
            LAS unsigned char* sb = lds + st * H3_STAGE;
            u32x2 vfu[2];
#pragma unroll
            for (int ss = 0; ss < 2; ++ss) {
                const LAS unsigned char* vp = sb + H3_V + (16 * ss + 4 * fq) * H3_VP + (16 * vt + lv) * 2;
                const unsigned e0 = *(const LAS bf16_t*)(vp), e1 = *(const LAS bf16_t*)(vp + H3_VP), e2 = *(const LAS bf16_t*)(vp + 2 * H3_VP), e3 = *(const LAS bf16_t*)(vp + 3 * H3_VP);
                vfu[ss].x = e0 | (e1 << 16); vfu[ss].y = e2 | (e3 << 16);
            }
            const s16x4 vf0 = __builtin_bit_cast(s16x4, vfu[0]), vf1 = __builtin_bit_cast(s16x4, vfu[1]);
            if (c > 0) H3_FLUSH(c - 1, st ^ 1);
            f32x4 o0 = (f32x4){0.f, 0.f, 0.f, 0.f}, o1 = o0;
#pragma unroll
            for (int k2 = 0; k2 < 2; ++k2) {
                u32x2 sbu; sbu.x = pk2(S[k2][0], S[k2][1]); sbu.y = pk2(S[k2][2], S[k2][3]);
                const s16x4 Sb = __builtin_bit_cast(s16x4, sbu);
                const LAS unsigned char* qp = sb + H3_Q + lv * H3_QP + (32 * kq + 16 * k2 + 4 * fq) * 2;
                const s16x4 a0 = *(const LAS s16x4*)qp, a1 = *(const LAS s16x4*)(qp + 16 * H3_QP);
                o0 = __builtin_amdgcn_mfma_f32_16x16x16bf16_1k(a0, Sb, o0, 0, 0, 0);
                o1 = __builtin_amdgcn_mfma_f32_16x16x16bf16_1k(a1, Sb, o1, 0, 0, 0);
            }
            if (kq < 3) {
                const LAS unsigned char* pp = sb + H3_P + (16 * (kq > 0 ? 1 : 0) + lv) * H3_PP + (16 * (kq == 2 ? 1 : 0) + 4 * fq) * 2;
                const s16x4 a = *(const LAS s16x4*)pp;
                if (kq == 0) o0 = __builtin_amdgcn_mfma_f32_16x16x16bf16_1k(a, vf0, o0, 0, 0, 0);
                else if (kq == 1) o1 = __builtin_amdgcn_mfma_f32_16x16x16bf16_1k(a, vf0, o1, 0, 0, 0);
                else o1 = __builtin_amdgcn_mfma_f32_16x16x16bf16_1k(a, vf1, o1, 0, 0, 0);
            }
#pragma unroll
            for (int k2 = 0; k2 < 2; ++k2) {
                const f32x4 dd = *(const LAS f32x4*)(sb + H3_D + (32 * kq + 16 * k2 + 4 * fq) * 4);
                S[k2] = S[k2] * dd;
                const LAS unsigned char* kp = sb + H3_K + (32 * kq + 16 * k2 + lv) * H3_KP + 4 * fq * 2;
                const s16x4 a0 = *(const LAS s16x4*)kp, a1 = *(const LAS s16x4*)(kp + 32);
                S[k2] = __builtin_amdgcn_mfma_f32_16x16x16bf16_1k(a0, vf0, S[k2], 0, 0, 0);
                S[k2] = __builtin_amdgcn_mfma_f32_16x16x16bf16_1k(a1, vf1, S[k2], 0, 0, 0);
            }
            { LAS float* ot = (LAS float*)(lds + H3_O + st * H3_OBYTES) + kq * 1024 + 16 * vt + lv;
#pragma unroll
              for (int i = 0; i < 4; ++i) { ot[(4 * fq + i) * 32] = o0[i]; ot[(16 + 4 * fq + i) * 32] = o1[i]; } }
            LDS_BARRIER();
          }
        }
        H3_FLUSH(255, 1);
#undef H3_FLUSH
#undef H3_GLOAD
#undef H3_LSTORE
        LDS_BARRIER();
    }
}

__device__ __forceinline__ void hg_norm_pass(bf16_t* IG, const float* ssq_o, const float* gain, int G, int bid) {
    int tid_l = threadIdx.x; asm volatile("" : "+v"(tid_l));
    const int tid = tid_l, wave = tid >> 6, lane = tid & 63, gw = bid * 8 + wave, NGW = G * 8;
    float gv[16];
#pragma unroll
    for (int j = 0; j < 16; ++j) gv[j] = gain[((16 * lane) & 127) + j];
    for (int row = gw; row < T; row += NGW) {
        bf16_t* rp = IG + (size_t)row * 2048 + 16 * lane;
        const u32x4 a0 = *(const u32x4*)rp, a1 = *(const u32x4*)(rp + 8), g0 = *(const u32x4*)(rp + 1024), g1 = *(const u32x4*)(rp + 1032);
        const float r = rsqrtf(ssq_o[(size_t)row * 8 + (lane >> 3)] * (1.0f / 128.0f) + EPS);
        u32x4 w0, w1;
#pragma unroll
        for (int q = 0; q < 4; ++q) {
            const float x0 = __uint_as_float(a0[q] << 16), x1 = __uint_as_float(a0[q] & 0xffff0000u), y0 = __uint_as_float(a1[q] << 16), y1 = __uint_as_float(a1[q] & 0xffff0000u);
            const float s0 = silu_f(__uint_as_float(g0[q] << 16)), s1 = silu_f(__uint_as_float(g0[q] & 0xffff0000u)), t0 = silu_f(__uint_as_float(g1[q] << 16)), t1 = silu_f(__uint_as_float(g1[q] & 0xffff0000u));
            w0[q] = pk2(x0 * r * gv[2 * q] * s0, x1 * r * gv[2 * q + 1] * s1);
            w1[q] = pk2(y0 * r * gv[8 + 2 * q] * t0, y1 * r * gv[8 + 2 * q + 1] * t1);
        }
        *(u32x4*)(rp + 1024) = w0; *(u32x4*)(rp + 1032) = w1;
    }
}

__device__ __forceinline__ void fin_head(const u32x4 a0, const u32x4 a1, const u32x2 r1, const u32x2 r2, const float (&gn)[16], const float (&g1)[4], const float (&g2)[4],
                                         const float (&sn)[4], const float (&cs)[4], float scale, u32x4& o0, u32x4& o1, u32x2& q1, u32x2& q2) {
    float v[16], x1[4], x2[4];
#pragma unroll
    for (int q = 0; q < 4; ++q) { v[2 * q] = __uint_as_float(a0[q] << 16); v[2 * q + 1] = __uint_as_float(a0[q] & 0xffff0000u); v[8 + 2 * q] = __uint_as_float(a1[q] << 16); v[8 + 2 * q + 1] = __uint_as_float(a1[q] & 0xffff0000u); }
#pragma unroll
    for (int q = 0; q < 2; ++q) { x1[2 * q] = __uint_as_float(r1[q] << 16); x1[2 * q + 1] = __uint_as_float(r1[q] & 0xffff0000u); x2[2 * q] = __uint_as_float(r2[q] << 16); x2[2 * q + 1] = __uint_as_float(r2[q] & 0xffff0000u); }
    float ss = 0.f;
#pragma unroll
    for (int j = 0; j < 16; ++j) ss += v[j] * v[j];
#pragma unroll
    for (int j = 0; j < 4; ++j) ss += x1[j] * x1[j] + x2[j] * x2[j];
    ss += __shfl_xor(ss, 1); ss += __shfl_xor(ss, 2); ss += __shfl_xor(ss, 4);
    const float r = rsqrtf(ss * (1.0f / 192.0f) + EPS) * scale;
#pragma unroll
    for (int j = 0; j < 16; ++j) v[j] = v[j] * r * gn[j];
    float z1[4], z2[4];
#pragma unroll
    for (int j = 0; j < 4; ++j) { const float y1 = x1[j] * r * g1[j], y2 = x2[j] * r * g2[j]; z1[j] = y1 * cs[j] - y2 * sn[j]; z2[j] = y2 * cs[j] + y1 * sn[j]; }
#pragma unroll
    for (int q = 0; q < 4; ++q) { o0[q] = pk2(v[2 * q], v[2 * q + 1]); o1[q] = pk2(v[8 + 2 * q], v[8 + 2 * q + 1]); }
#pragma unroll
    for (int q = 0; q < 2; ++q) { q1[q] = pk2(z1[2 * q], z1[2 * q + 1]); q2[q] = pk2(z2[2 * q], z2[2 * q + 1]); }
}
__device__ __forceinline__ void mla_finalize(bf16_t* Q, bf16_t* KF, const bf16_t* kpe, const int* positions, const float* gq, const float* gk, int G, int bid) {
    int tid_l = threadIdx.x; asm volatile("" : "+v"(tid_l));
    const int tid = tid_l, wave = tid >> 6, lane = tid & 63, h = lane >> 3, p = lane & 7;
    const int gw = bid * 8 + wave, NGW = G * 8;
    float gqn[16], gq1[4], gq2[4], gkn[16], gk1[4], gk2[4], invf[4];
#pragma unroll
    for (int j = 0; j < 16; ++j) { gqn[j] = gq[16 * p + j]; gkn[j] = gk[16 * p + j]; }
#pragma unroll
    for (int j = 0; j < 4; ++j) { gq1[j] = gq[128 + 4 * p + j]; gq2[j] = gq[160 + 4 * p + j]; gk1[j] = gk[128 + 4 * p + j]; gk2[j] = gk[160 + 4 * p + j];
        invf[j] = exp2f(-(float)(4 * p + j) * 0.41524101186092029f); }
    for (int row = gw; row < T; row += NGW) {
        const float pos = (float)positions[row];
        float sn[4], cs[4];
#pragma unroll
        for (int j = 0; j < 4; ++j) { const float ang = pos * invf[j]; const double rev = (double)ang * 0.15915494309189535; const float frc = (float)(rev - rint(rev));
            sn[j] = __builtin_amdgcn_sinf(frc); cs[j] = __builtin_amdgcn_cosf(frc); }
        { bf16_t* kb = KF + (size_t)row * 1536 + 192 * h; const bf16_t* kp = kpe + (size_t)row * 64;
          const u32x4 a0 = *(const u32x4*)(kb + 16 * p), a1 = *(const u32x4*)(kb + 16 * p + 8); const u32x2 r1 = *(const u32x2*)(kp + 4 * p), r2 = *(const u32x2*)(kp + 32 + 4 * p);
          u32x4 o0, o1; u32x2 q1, q2;
          fin_head(a0, a1, r1, r2, gkn, gk1, gk2, sn, cs, 1.0f, o0, o1, q1, q2);
          *(u32x4*)(kb + 16 * p) = o0; *(u32x4*)(kb + 16 * p + 8) = o1; *(u32x2*)(kb + 128 + 4 * p) = q1; *(u32x2*)(kb + 160 + 4 * p) = q2; }
    }
}

typedef __amdgpu_buffer_rsrc_t bufrsrc_t;
constexpr int AT_KP = 400, AT_VP = 144, AT_KBYTES = 64 * AT_KP, AT_STAGE = AT_KBYTES + 128 * AT_VP;
template <int MODE> __device__ __forceinline__ void attn_phase(LAS unsigned char* lds, const bf16_t* Q, const bf16_t* KF, const bf16_t* VT, bf16_t* O, const int* positions, const float* gq, int G, int bid) {
    int tid_l = threadIdx.x; asm volatile("" : "+v"(tid_l));
    const int tid = tid_l, w = tid >> 6, lane = tid & 63, lq = lane & 31, hi = lane >> 5;
    const unsigned kvo = (unsigned)((tid >> 3) * 1536 + 8 * (tid & 7));
    const unsigned vvo = (unsigned)((tid >> 3) * T + 8 * (tid & 7));
    const unsigned klo = (unsigned)((tid >> 3) * AT_KP + (tid & 7) * 16);
    const unsigned vlo = (unsigned)(AT_KBYTES + (tid >> 3) * AT_VP + ((tid & 7) >> 1) * 32 + (tid & 1) * 8);
    for (int it = bid; it < 1024; it += G) {
        const int bh = it >> 4, pp = it & 15, b = bh >> 3, h = bh & 7;
        for (int half = 0; half < 2; ++half) {
            const int j = half ? 31 - pp : pp;
            const int ntiles = 4 * j + 4, my_last = 4 * j + (w >> 1);
            const size_t qrow = (size_t)b * SEQ + 256 * j + 32 * w + lq;
            bf16x8 qf[12];
#pragma unroll
            for (int kk = 0; kk < 12; ++kk) qf[kk] = *(const bf16x8*)(Q + qrow * 1536 + 192 * h + 16 * kk + 8 * hi);
            {
                float ss = 0.f;
#pragma unroll
                for (int kk = 0; kk < 12; ++kk)
#pragma unroll
                    for (int j = 0; j < 8; ++j) { const float v = bf2f((bf16_t)qf[kk][j]); ss += v * v; }
                ss += __shfl_xor(ss, 32);
                const float r = rsqrtf(ss * (1.0f / 192.0f) + EPS) * QSCALE;
#pragma unroll
                for (int kk = 0; kk < 8; ++kk) {
                    const f32x4 g0 = *(const f32x4*)(gq + 16 * kk + 8 * hi), g1 = *(const f32x4*)(gq + 16 * kk + 8 * hi + 4);
#pragma unroll
                    for (int q2 = 0; q2 < 4; ++q2) {
                        const float a = bf2f((bf16_t)qf[kk][2 * q2]) * r * ((q2 < 2) ? g0[2 * q2] : g1[2 * q2 - 4]);
                        const float c = bf2f((bf16_t)qf[kk][2 * q2 + 1]) * r * ((q2 < 2) ? g0[2 * q2 + 1] : g1[2 * q2 - 3]);
                        const unsigned pk = pk2(a, c); qf[kk][2 * q2] = (short)(pk & 0xffff); qf[kk][2 * q2 + 1] = (short)(pk >> 16);
                    }
                }
                const float pos = (float)positions[qrow];
#pragma unroll
                for (int kk = 8; kk < 10; ++kk) {
                    const f32x4 ga0 = *(const f32x4*)(gq + 16 * kk + 8 * hi), ga1 = *(const f32x4*)(gq + 16 * kk + 8 * hi + 4);
                    const f32x4 gb0 = *(const f32x4*)(gq + 16 * kk + 32 + 8 * hi), gb1 = *(const f32x4*)(gq + 16 * kk + 32 + 8 * hi + 4);
                    float z1[8], z2[8];
#pragma unroll
                    for (int j = 0; j < 8; ++j) {
                        const int i = 16 * (kk - 8) + 8 * hi + j;
                        const float ang = pos * exp2f(-(float)i * 0.41524101186092029f);
                        const double rev = (double)ang * 0.15915494309189535; const float frc = (float)(rev - rint(rev));
                        const float sn = __builtin_amdgcn_sinf(frc), cs = __builtin_amdgcn_cosf(frc);
                        const float y1 = bf2f((bf16_t)qf[kk][j]) * r * ((j < 4) ? ga0[j] : ga1[j - 4]);
                        const float y2 = bf2f((bf16_t)qf[kk + 2][j]) * r * ((j < 4) ? gb0[j] : gb1[j - 4]);
                        z1[j] = y1 * cs - y2 * sn; z2[j] = y2 * cs + y1 * sn;
                    }
#pragma unroll
                    for (int q2 = 0; q2 < 4; ++q2) {
                        const unsigned p1 = pk2(z1[2 * q2], z1[2 * q2 + 1]), p2 = pk2(z2[2 * q2], z2[2 * q2 + 1]);
                        qf[kk][2 * q2] = (short)(p1 & 0xffff); qf[kk][2 * q2 + 1] = (short)(p1 >> 16);
                        qf[kk + 2][2 * q2] = (short)(p2 & 0xffff); qf[kk + 2][2 * q2 + 1] = (short)(p2 >> 16);
                    }
                }
            }
            f32x16 o[4];
#pragma unroll
            for (int db = 0; db < 4; ++db)
#pragma unroll
                for (int i = 0; i < 16; ++i) o[db][i] = 0.f;
            float mrun = 0.f, lsum = 0.f;
            const bf16_t* kg = KF + (size_t)b * SEQ * 1536 + 192 * h;
            const bf16_t* vg = VT + (size_t)(128 * h) * T + (size_t)b * SEQ;
            u32x4 kr[3], vr[2];
            const bufrsrc_t krs = __builtin_amdgcn_make_buffer_rsrc((void*)kg, 0, 0x7fffffff, 0x00020000), vrs = __builtin_amdgcn_make_buffer_rsrc((void*)vg, 0, 0x7fffffff, 0x00020000);
#define AT_GLOAD_K(kt_) do { const int so_ = ((MODE == 1) ? 0 : (kt_)) * (64 * 1536 * 2); \
                _Pragma("unroll") for (int i = 0; i < 3; ++i) kr[i] = __builtin_bit_cast(u32x4, __builtin_amdgcn_raw_buffer_load_b128(krs, (int)(kvo * 2u) + 128 * i, so_, 0)); } while (0)
#define AT_GLOAD_V(kt_) do { const int so_ = ((MODE == 1) ? 0 : (kt_)) * 128; \
                vr[0] = __builtin_bit_cast(u32x4, __builtin_amdgcn_raw_buffer_load_b128(vrs, (int)(vvo * 2u), so_, 0)); \
                vr[1] = __builtin_bit_cast(u32x4, __builtin_amdgcn_raw_buffer_load_b128(vrs, (int)(vvo * 2u), so_ + 64 * T * 2, 0)); } while (0)
#define AT_LSTORE_K(buf_) do { LAS unsigned char* nb_ = lds + (buf_) * AT_STAGE; \
                _Pragma("unroll") for (int i = 0; i < 3; ++i) *(LAS u32x4*)(nb_ + klo + 128 * i) = kr[i]; } while (0)
#define AT_LSTORE_V(buf_) do { LAS unsigned char* nb_ = lds + (buf_) * AT_STAGE; \
                *(LAS u32x2*)(nb_ + vlo) = (u32x2){vr[0].x, vr[0].y}; *(LAS u32x2*)(nb_ + vlo + 16) = (u32x2){vr[0].z, vr[0].w}; \
                *(LAS u32x2*)(nb_ + vlo + 64 * AT_VP) = (u32x2){vr[1].x, vr[1].y}; *(LAS u32x2*)(nb_ + vlo + 64 * AT_VP + 16) = (u32x2){vr[1].z, vr[1].w}; } while (0)
#define AT_LSTORE(buf_) do { AT_LSTORE_K(buf_); AT_LSTORE_V(buf_); } while (0)
            AT_GLOAD_K(0); AT_GLOAD_V(0);
            AT_LSTORE(0);
            __syncthreads();
            for (int kt = 0; kt < ntiles; ++kt) {
                const bool more = (kt + 1 < ntiles);
                if (more && MODE < 3) { AT_GLOAD_K(kt + 1); AT_GLOAD_V(kt + 1); }
                if (kt <= my_last) {
                    LAS unsigned char* kb = lds + (kt & 1) * AT_STAGE; LAS unsigned char* vb = kb + AT_KBYTES;
#define AT_RESCALE(EXTRA) do { const float d_ = fmaxf(mx, 0.f), alpha_ = __builtin_amdgcn_exp2f(-d_); mrun += d_; lsum *= alpha_; \
                        _Pragma("unroll") for (int db = 0; db < 4; ++db) _Pragma("unroll") for (int i = 0; i < 16; ++i) o[db][i] *= alpha_; EXTRA } while (0)
                    f32x16 s0, s1;
#pragma unroll
                    for (int i = 0; i < 16; ++i) s0[i] = -mrun;
                    bf16x8 fr[8], fr2[4];
#pragma unroll
                    for (int kk = 0; kk < 8; ++kk) fr[kk] = *(const LAS bf16x8*)(kb + lq * AT_KP + (16 * kk + 8 * hi) * 2);
                    __builtin_amdgcn_sched_barrier(0);
#pragma unroll
                    for (int kk = 0; kk < 4; ++kk) s0 = __builtin_amdgcn_mfma_f32_32x32x16_bf16(fr[kk], qf[kk], s0, 0, 0, 0);
                    __builtin_amdgcn_sched_barrier(0);
#pragma unroll
                    for (int kk = 8; kk < 12; ++kk) fr2[kk - 8] = *(const LAS bf16x8*)(kb + lq * AT_KP + (16 * kk + 8 * hi) * 2);
                    __builtin_amdgcn_sched_barrier(0);
#pragma unroll
                    for (int kk = 4; kk < 8; ++kk) s0 = __builtin_amdgcn_mfma_f32_32x32x16_bf16(fr[kk], qf[kk], s0, 0, 0, 0);
#pragma unroll
                    for (int kk = 8; kk < 12; ++kk) s0 = __builtin_amdgcn_mfma_f32_32x32x16_bf16(fr2[kk - 8], qf[kk], s0, 0, 0, 0);
                    __builtin_amdgcn_sched_barrier(0);
#pragma unroll
                    for (int kk = 0; kk < 8; ++kk) fr[kk] = *(const LAS bf16x8*)(kb + (32 + lq) * AT_KP + (16 * kk + 8 * hi) * 2);
                    __builtin_amdgcn_sched_barrier(0);
                    float mx = fmaxf(fmaxf(s0[0], s0[1]), fmaxf(s0[2], s0[3]));
#pragma unroll
                    for (int i = 4; i < 16; i += 2) mx = fmaxf(mx, fmaxf(s0[i], s0[i + 1]));
                    mx = fmaxf(mx, __shfl_xor(mx, 32));
                    if (__any(mx > 6.0f)) AT_RESCALE(_Pragma("unroll") for (int i = 0; i < 16; ++i) s0[i] -= d_;);
#pragma unroll
                    for (int i = 0; i < 16; ++i) s1[i] = -mrun;
                    __builtin_amdgcn_sched_barrier(0);
                    float ps = 0.f;
#pragma unroll
                    for (int kk = 0; kk < 4; ++kk) s1 = __builtin_amdgcn_mfma_f32_32x32x16_bf16(fr[kk], qf[kk], s1, 0, 0, 0);
#pragma unroll
                    for (int i = 0; i < 5; ++i) { s0[i] = __builtin_amdgcn_exp2f(s0[i]); ps += s0[i]; }
#pragma unroll
                    for (int g = 0; g < 4; ++g) { __builtin_amdgcn_sched_group_barrier(0x008, 1, 0); __builtin_amdgcn_sched_group_barrier(0x002, 3, 0); }
                    __builtin_amdgcn_sched_barrier(0);
#pragma unroll
                    for (int kk = 8; kk < 12; ++kk) fr2[kk - 8] = *(const LAS bf16x8*)(kb + (32 + lq) * AT_KP + (16 * kk + 8 * hi) * 2);
                    __builtin_amdgcn_sched_barrier(0);
#pragma unroll
                    for (int kk = 4; kk < 8; ++kk) s1 = __builtin_amdgcn_mfma_f32_32x32x16_bf16(fr[kk], qf[kk], s1, 0, 0, 0);
#pragma unroll
                    for (int kk = 8; kk < 12; ++kk) s1 = __builtin_amdgcn_mfma_f32_32x32x16_bf16(fr2[kk - 8], qf[kk], s1, 0, 0, 0);
#pragma unroll
                    for (int i = 5; i < 16; ++i) { s0[i] = __builtin_amdgcn_exp2f(s0[i]); ps += s0[i]; }
#pragma unroll
                    for (int g = 0; g < 8; ++g) { __builtin_amdgcn_sched_group_barrier(0x008, 1, 0); __builtin_amdgcn_sched_group_barrier(0x002, 3, 0); }
                    __builtin_amdgcn_sched_barrier(0);
                    bf16x8 va[8];
#pragma unroll
                    for (int ks = 0; ks < 2; ++ks)
#pragma unroll
                        for (int db = 0; db < 4; ++db) va[ks * 4 + db] = *(const LAS bf16x8*)(vb + (32 * db + lq) * AT_VP + (16 * ks + 8 * hi) * 2);
                    __builtin_amdgcn_sched_barrier(0);
                    mx = fmaxf(fmaxf(s1[0], s1[1]), fmaxf(s1[2], s1[3]));
#pragma unroll
                    for (int i = 4; i < 16; i += 2) mx = fmaxf(mx, fmaxf(s1[i], s1[i + 1]));
                    mx = fmaxf(mx, __shfl_xor(mx, 32));
                    if (__any(mx > 6.0f)) AT_RESCALE(ps *= alpha_; _Pragma("unroll") for (int i = 0; i < 16; ++i) { s0[i] *= alpha_; s1[i] -= d_; });
                    lsum += ps;
                    bf16x8 pb[2];
#pragma unroll
                    for (int ks = 0; ks < 2; ++ks)
#pragma unroll
                        for (int q = 0; q < 4; ++q) { const unsigned pk = pk2(s0[8 * ks + 2 * q], s0[8 * ks + 2 * q + 1]); pb[ks][2 * q] = (short)(pk & 0xffff); pb[ks][2 * q + 1] = (short)(pk >> 16); }
                    __builtin_amdgcn_sched_barrier(0);
#pragma unroll
                    for (int ks = 0; ks < 2; ++ks)
#pragma unroll
                        for (int db = 0; db < 4; ++db) o[db] = __builtin_amdgcn_mfma_f32_32x32x16_bf16(va[ks * 4 + db], pb[ks], o[db], 0, 0, 0);
                    float ps1 = 0.f;
#pragma unroll
                    for (int i = 0; i < 16; ++i) { s1[i] = __builtin_amdgcn_exp2f(s1[i]); ps1 += s1[i]; }
#pragma unroll
                    for (int g = 0; g < 8; ++g) { __builtin_amdgcn_sched_group_barrier(0x008, 1, 0); __builtin_amdgcn_sched_group_barrier(0x002, 4, 0); }
                    __builtin_amdgcn_sched_barrier(0);
                    lsum += ps1;
#pragma unroll
                    for (int ks = 0; ks < 2; ++ks)
#pragma unroll
                        for (int db = 0; db < 4; ++db) va[ks * 4 + db] = *(const LAS bf16x8*)(vb + (32 * db + lq) * AT_VP + (16 * (ks + 2) + 8 * hi) * 2);
                    if (more && MODE < 3) AT_LSTORE((kt + 1) & 1);
                    __builtin_amdgcn_sched_barrier(0);
#pragma unroll
                    for (int ks = 0; ks < 2; ++ks)
#pragma unroll
                        for (int q = 0; q < 4; ++q) { const unsigned pk = pk2(s1[8 * ks + 2 * q], s1[8 * ks + 2 * q + 1]); pb[ks][2 * q] = (short)(pk & 0xffff); pb[ks][2 * q + 1] = (short)(pk >> 16); }
                    __builtin_amdgcn_sched_barrier(0);
#pragma unroll
                    for (int ks = 0; ks < 2; ++ks)
#pragma unroll
                        for (int db = 0; db < 4; ++db) o[db] = __builtin_amdgcn_mfma_f32_32x32x16_bf16(va[ks * 4 + db], pb[ks], o[db], 0, 0, 0);
#undef AT_RESCALE
                }
                if (more && MODE < 3 && kt > my_last) AT_LSTORE((kt + 1) & 1);
                if (MODE != 4) __syncthreads();
            }
#undef AT_GLOAD_K
#undef AT_GLOAD_V
#undef AT_LSTORE
#undef AT_LSTORE_K
#undef AT_LSTORE_V
            lsum += __shfl_xor(lsum, 32);
            const float inv = 1.0f / lsum;
            int t2 = threadIdx.x; asm volatile("" : "+v"(t2));
            const size_t qrow2 = (size_t)b * SEQ + 256 * j + 32 * (t2 >> 6) + (t2 & 31);
            bf16_t* op = O + qrow2 * 2048 + 128 * h;
#pragma unroll
            for (int db = 0; db < 4; ++db)
#pragma unroll
                for (int g4 = 0; g4 < 4; ++g4) {
                    u32x2 wv; wv.x = pk2(o[db][4 * g4] * inv, o[db][4 * g4 + 1] * inv); wv.y = pk2(o[db][4 * g4 + 2] * inv, o[db][4 * g4 + 3] * inv);
                    *(u32x2*)(op + 32 * db + 8 * g4 + 4 * hi) = wv;
                }
        }
    }
}

#ifndef PH_MASK
#define PH_MASK 0xFFFFF
#endif
__global__ void __launch_bounds__(512, 2) fwd_megakernel(Params p) {
    extern __shared__ __attribute__((aligned(16))) unsigned char lds_raw[];
    LAS unsigned char* lds = (LAS unsigned char*)lds_raw;
    cg::grid_group grid = cg::this_grid();
    const int G = gridDim.x, bid = blockIdx.x;
#define FRESH_LANE_IDS int tid_l = threadIdx.x; asm volatile("" : "+v"(tid_l)); const int wave = tid_l >> 6, lane = tid_l & 63, gw = bid * 8 + wave, NGW = G * 8
#define WSB karg_ws()
#define OUTP karg_out()
#define ssq_mix ((float*)(WSB + WS_SSQ_MIX))
#define ssq_cq ((float*)(WSB + WS_SSQ_CQ))
#define ssq_ckv ((float*)(WSB + WS_SSQ_CKV))
#define ssq2 ((float*)(WSB + WS_SSQ2))
#define R3 ((bf16_t*)(WSB + WS_R3))
#define IG ((bf16_t*)(WSB + WS_IG))
#define QF ((bf16_t*)(WSB + WS_QF))
#define HID ((bf16_t*)(WSB + WS_HID))
#define KF ((bf16_t*)(WSB + WS_KF))
#define cqg ((bf16_t*)(WSB + WS_CQG))
#define ckvg ((bf16_t*)(WSB + WS_CKVG))
#define kpe ((bf16_t*)(WSB + WS_KPE))
#define HB ((bf16_t*)OUTP)
#define HGM (((bf16_t*)OUTP) + (size_t)T * DM)
#define H3 ((bf16_t*)(WSB + 544 * MiB))

    if constexpr (PH_MASK & 1) prologue(lds, G, bid);
    grid.sync();
    if constexpr (PH_MASK & 2) { EpiSwiglu E{HID, nullptr}; run_gemm(lds, R3, (const bf16_t*)(WSB + WS_W1IN), T, 5632, 1024, E, G, bid); }
    grid.sync();
    if constexpr (PH_MASK & 4) { EpiRes<float, bf16_t, 1> E{karg_in(0), HB, HGM, karg_in(5), ssq_mix}; run_gemm(lds, HID, (const bf16_t*)(WSB + WS_W1OUT), T, 1024, DFF, E, G, bid); }
    grid.sync();
    if constexpr (PH_MASK & 8) { EpiIn E{QF, IG, cqg, ckvg, kpe, ssq_mix, ssq_cq, ssq_ckv, karg_in(10), karg_in(12)}; run_gemm(lds, HGM, (const bf16_t*)(WSB + WS_WIN), T, NIN, 1024, E, G, bid); }
    grid.sync();
    if constexpr (PH_MASK & 16) {
        FRESH_LANE_IDS;
        for (int m = gw; m < T; m += NGW) {
            const float rq = rsqrtf(ssq_cq[m] * (1.0f / 384.0f) + EPS), rk = rsqrtf(ssq_ckv[m] * (1.0f / 256.0f) + EPS);
            if (lane < 48) { u32x4* pq = (u32x4*)(cqg + (size_t)m * 384) + lane; u32x4 v = *pq;
#pragma unroll
                for (int q = 0; q < 4; ++q) v[q] = pk2(__uint_as_float(v[q] << 16) * rq, __uint_as_float(v[q] & 0xffff0000u) * rq);
                *pq = v; }
            if (lane < 32) { u32x4* pk = (u32x4*)(ckvg + (size_t)m * 256) + lane; u32x4 v = *pk;
#pragma unroll
                for (int q = 0; q < 4; ++q) v[q] = pk2(__uint_as_float(v[q] << 16) * rk, __uint_as_float(v[q] & 0xffff0000u) * rk);
                *pk = v; }
        }
    }
    if constexpr (PH_MASK & 16) hg_prepass(lds, QF, karg_in(7), (bf16_t*)(WSB + WS_P), (float*)(WSB + WS_ER), G, bid);
    grid.sync();
    if constexpr (PH_MASK & 32) hg_recur(lds, QF, IG, (const bf16_t*)(WSB + WS_P), (const float*)(WSB + WS_ER), (float*)(WSB + WS_SSQO), G, bid);
    grid.sync();
    if constexpr (PH_MASK & 32) hg_norm_pass(IG, (const float*)(WSB + WS_SSQO), karg_in(8), G, bid);
    if constexpr (PH_MASK & 64) { EpiPlain<1536, 128> E{QF}; run_gemm(lds, cqg, (const bf16_t*)(WSB + WS_WQ), T, 1536, 384, E, G, bid); }
    if constexpr (PH_MASK & 64) { EpiPlain<1536, 192> E{KF}; run_gemm(lds, ckvg, (const bf16_t*)(WSB + WS_WKV), T, 1024, 256, E, G, bid); }
    if constexpr (PH_MASK & 128) { EpiPlain<T, 128> E{R3}; run_gemm(lds, (const bf16_t*)(WSB + WS_WKV) + (size_t)1024 * 256, ckvg, 1024, T, 256, E, G, bid); }
    grid.sync();
    if constexpr (PH_MASK & 256) mla_finalize(QF, KF, kpe, (const int*)karg_in(1), karg_in(14), karg_in(15), G, bid);
    grid.sync();
    if constexpr (PH_MASK & 512) attn_phase<0>(lds, QF, KF, R3, IG, (const int*)karg_in(1), karg_in(14), G, bid);
    grid.sync();
    if constexpr (PH_MASK & 1024) { EpiGate E{QF, ssq_mix, karg_in(18)}; run_gemm(lds, HGM, (const bf16_t*)(WSB + WS_WMG), T, 2048, 1024, E, G, bid); }
    grid.sync();
    if constexpr (PH_MASK & 2048) { EpiBranch<false> E{QF, 1024, cqg, nullptr}; run_gemm(lds, IG, (const bf16_t*)(WSB + WS_WBR), T, 1024, 1024, E, G, bid, 2048, 2048); }
    if constexpr (PH_MASK & 2048) { EpiBranch<true> E{QF, 0, cqg, R3}; run_gemm(lds, IG + 1024, (const bf16_t*)(WSB + WS_WBR) + 1024, T, 1024, 1024, E, G, bid, 2048, 2048); }
    grid.sync();
    if constexpr (PH_MASK & 4096) { EpiRes<bf16_t, bf16_t, 2> E{HB, HB, KF, karg_in(20), ssq2}; run_gemm(lds, R3, (const bf16_t*)(WSB + WS_WOUT), T, 1024, 1024, E, G, bid); }
    grid.sync();
    if constexpr (PH_MASK & 8192) { EpiSwiglu E{HID, ssq2}; run_gemm(lds, KF, (const bf16_t*)(WSB + WS_W2IN), T, 5632, 1024, E, G, bid); }
    grid.sync();
    if constexpr (PH_MASK & 16384) { EpiRes<bf16_t, bf16_t, 1> E{HB, H3, nullptr, nullptr, nullptr}; run_gemm(lds, HID, (const bf16_t*)(WSB + WS_W2OUT), T, 1024, DFF, E, G, bid); }
    grid.sync();
    { FRESH_LANE_IDS;
    for (int m = gw; m < T; m += NGW) {
        const u32x2* xr = (const u32x2*)(H3 + (size_t)m * DM) + lane; f32x4* orow = (f32x4*)(OUTP + (size_t)m * DM) + lane; const f32x4* gr = (const f32x4*)karg_in(23) + lane;
        f32x4 v[4]; float s = 0.f;
#pragma unroll
        for (int j = 0; j < 4; ++j) { const u32x2 a = xr[64 * j];
            v[j] = (f32x4){__uint_as_float(a.x << 16), __uint_as_float(a.x & 0xffff0000u), __uint_as_float(a.y << 16), __uint_as_float(a.y & 0xffff0000u)};
            s += (v[j].x * v[j].x + v[j].y * v[j].y) + (v[j].z * v[j].z + v[j].w * v[j].w); }
        const float r = rsqrtf(wave_sum(s) * (1.0f / DM) + EPS);
#pragma unroll
        for (int j = 0; j < 4; ++j) orow[64 * j] = v[j] * r * gr[64 * j];
    } }
#if defined(PROBE_PHASE)
    grid.sync();
#if PROBE_PHASE == 1
    attn_phase<0>(lds, QF, KF, R3, IG, (const int*)karg_in(1), karg_in(14), G, bid);
#elif PROBE_PHASE == 10
    attn_phase<1>(lds, QF, KF, R3, IG, (const int*)karg_in(1), karg_in(14), G, bid);
#elif PROBE_PHASE == 12
    attn_phase<2>(lds, QF, KF, R3, IG, (const int*)karg_in(1), karg_in(14), G, bid);
#elif PROBE_PHASE == 13
    attn_phase<3>(lds, QF, KF, R3, IG, (const int*)karg_in(1), karg_in(14), G, bid);
#elif PROBE_PHASE == 14
    attn_phase<4>(lds, QF, KF, R3, IG, (const int*)karg_in(1), karg_in(14), G, bid);
#elif PROBE_PHASE == 2
    hg_recur(lds, QF, IG, (const bf16_t*)(WSB + WS_P), (const float*)(WSB + WS_ER), (float*)(WSB + WS_SSQO), G, bid);
#elif PROBE_PHASE == 3
    hg_prepass(lds, QF, karg_in(7), (bf16_t*)(WSB + WS_P), (float*)(WSB + WS_ER), G, bid);
#elif PROBE_PHASE == 4
    prologue(lds, G, bid);
#elif PROBE_PHASE == 6
    { EpiSwiglu E{HID, ssq2}; run_gemm(lds, KF, (const bf16_t*)(WSB + WS_W2IN), T, 5632, 1024, E, G, bid); }
#elif PROBE_PHASE == 7
    { EpiRes<bf16_t, float, 1> E{HB, (float*)(WSB + 600 * MiB), nullptr, nullptr, nullptr}; run_gemm(lds, HID, (const bf16_t*)(WSB + WS_W2OUT), T, 1024, DFF, E, G, bid); }
#elif PROBE_PHASE == 8
    { EpiIn E{QF, IG, cqg, ckvg, kpe, ssq_mix, ssq_cq, ssq_ckv, karg_in(10), karg_in(12)}; run_gemm(lds, R3, (const bf16_t*)(WSB + WS_WIN), T, NIN, 1024, E, G, bid); }
#elif PROBE_PHASE == 9
    { EpiGate E{QF, ssq_mix, karg_in(18)}; run_gemm(lds, R3, (const bf16_t*)(WSB + WS_WMG), T, 2048, 1024, E, G, bid); }
#elif PROBE_PHASE == 11
    { EpiPlain<1536, 128> E{QF}; run_gemm(lds, cqg, (const bf16_t*)(WSB + WS_WQ), T, 1536, 384, E, G, bid); }
    { EpiPlain<1536, 192> E{KF}; run_gemm(lds, ckvg, (const bf16_t*)(WSB + WS_WKV), T, 1024, 256, E, G, bid); }
    { EpiPlain<T, 128> E{R3}; run_gemm(lds, (const bf16_t*)(WSB + WS_WKV) + (size_t)1024 * 256, ckvg, 1024, T, 256, E, G, bid); }
#elif PROBE_PHASE == 5
    mla_finalize(QF, KF, kpe, (const int*)karg_in(1), karg_in(14), karg_in(15), G, bid);
#endif
#endif
}

extern "C" void kernel_launch(void* const* d_in, const int* in_sizes, int n_in, void* d_out, int out_size, void* d_ws, size_t ws_size, hipStream_t stream) {
    static int grid_blocks = 0;
    if (grid_blocks == 0) {
        if (n_in != 24 || out_size != T * DM || ws_size < WS_NEED) { fprintf(stderr, "kernel_launch: unexpected shapes (n_in %d out %d ws %zu)\n", n_in, out_size, ws_size); grid_blocks = -1; return; }
        int dev = 0, cus = 0, per_cu = 0;
        hipGetDevice(&dev);
        hipDeviceGetAttribute(&cus, hipDeviceAttributeMultiprocessorCount, dev);
        if (hipFuncSetAttribute((const void*)fwd_megakernel, hipFuncAttributeMaxDynamicSharedMemorySize, LDS_BYTES) != hipSuccess) { fprintf(stderr, "kernel_launch: hipFuncSetAttribute failed\n"); grid_blocks = -1; return; }
        if (hipOccupancyMaxActiveBlocksPerMultiprocessor(&per_cu, (const void*)fwd_megakernel, 512, LDS_BYTES) != hipSuccess || per_cu < 1) { fprintf(stderr, "kernel_launch: occupancy query gave %d\n", per_cu); per_cu = 1; (void)hipGetLastError(); }
        grid_blocks = cus * per_cu;
    }
    if (grid_blocks < 0) return;
    Params p{};
    for (int i = 0; i < 24; ++i) p.in[i] = (const float*)d_in[i];
    p.out = (float*)d_out; p.ws = (unsigned char*)d_ws;
    void* args[] = {&p};
    hipError_t e = hipLaunchCooperativeKernel((const void*)fwd_megakernel, dim3(grid_blocks), dim3(512), args, LDS_BYTES, stream);
    if (e != hipSuccess) fprintf(stderr, "cooperative launch failed: %s (grid %d)\n", hipGetErrorString(e), grid_blocks);
}
```

```cpp
#include <hip/hip_runtime.h>
#include <hip/hip_cooperative_groups.h>
#include <cstdio>
#include <cstdint>
namespace cg = cooperative_groups;
namespace pg8 {
#define PG8_LAS __attribute__((address_space(3)))
typedef unsigned short bf16_t;
typedef short bf16x8 __attribute__((ext_vector_type(8)));
typedef float f32x4 __attribute__((ext_vector_type(4)));
typedef unsigned u32x4 __attribute__((ext_vector_type(4)));
constexpr int BM = 256, BK = 64, HALF = 128, HTB = HALF * BK * 2  , STAGE_BYTES = 8 * HTB, NXCD = 8, WGM = 8;

__host__ __device__ __forceinline__ int lds_byte(int r, int c) { const int st = (r >> 4) * 2 + (c >> 5), rr = r & 15, cc = c & 31, ob = rr * 64 + cc * 2; return st * 1024 + (ob ^ (((ob >> 9) & 1) << 5)); }
__host__ __device__ __forceinline__ void stage_rc(int b, int& R, int& C) { const int st = b / 1024, sb = b % 1024, swz = sb ^ (((sb >> 9) & 1) << 5); R = (st >> 1) * 16 + swz / 64; C = (st & 1) * 32 + (swz % 64) / 2; }
__host__ __device__ __forceinline__ int perm32(int rho) { const int n = rho >> 4, i = rho & 15; return 8 * (i >> 2) + 4 * n + (i & 3); }

struct Unit { int pm, pn; };
struct Gemm { const bf16_t* A; const bf16_t* Bt; int M, N, K, lda, ldb; };

struct StaticOrder {
    int nM, nN, nwg, G, c;
    __host__ __device__ void init(int M, int N, int G_, int c_) { nM = M / BM; nN = N / BM; nwg = nM * nN; G = G_; c = c_; }
    __host__ __device__ bool next(int i, Unit& u) const {
        const long L = (long)i * G + c; if (L >= nwg) return false;
        int wgid = (int)L; { const int q = nwg / NXCD, r = nwg % NXCD, xcd = wgid % NXCD, off = wgid / NXCD; wgid = (xcd < r ? xcd * (q + 1) : r * (q + 1) + (xcd - r) * q) + off; }
        const int nig = WGM * nN, gid = wgid / nig, fm = gid * WGM, gsz = (nM - fm) < WGM ? (nM - fm) : WGM;
        u.pm = fm + ((wgid % nig) % gsz); u.pn = (wgid % nig) / gsz; return true;
    }
    __device__ __forceinline__ void a_ready(const Unit&) const {}
    __device__ __forceinline__ void done(const Unit&) const {}
};

__device__ __forceinline__ unsigned cvt_pk_bf16(float lo, float hi) { unsigned r; asm volatile("v_cvt_pk_bf16_f32 %0, %1, %2" : "=v"(r) : "v"(lo), "v"(hi)); return r; }
typedef float f32x2 __attribute__((ext_vector_type(2)));
template <class Epi, class Sched, bool ALIGN_EPI = false, bool SP2 = false>
__device__ __forceinline__ void gemm_phase(PG8_LAS unsigned char* lds, const Gemm g, const Sched& S, const Epi& E) {
    int tid_l = threadIdx.x; asm volatile("" : "+v"(tid_l));
    const int tid = tid_l, wid = __builtin_amdgcn_readfirstlane(tid >> 6), lane = tid & 63, wr = wid >> 2, wc = wid & 3, fr = lane & 15, fq = lane >> 4;
    int Kopaque = g.K; asm volatile("" : "+s"(Kopaque));
    const int K = Kopaque, nt = K / BK;
    unsigned voffA[2], voffB[2];
#pragma unroll
    for (int i = 0; i < 2; ++i) { int R, C; stage_rc(tid * 16 + i * 8192, R, C); const int Rb = Epi::PERM ? ((R & ~31) + perm32(R & 31)) : R;
        voffA[i] = (unsigned)(R * g.lda + C) * 2u; voffB[i] = (unsigned)(Rb * g.ldb + C) * 2u; }
    const size_t kstep = (size_t)(BK * 2);
    const size_t hstepA = (size_t)HALF * g.lda * 2, hstepB = (size_t)HALF * g.ldb * 2;
    const size_t tstepA = 2 * hstepA, tstepB = 2 * hstepB;
    const unsigned ldsw = (unsigned)wid * 1024u;
    const int aoff = lds_byte(wr * 64 + fr, fq * 8), boff = lds_byte(wc * 32 + fr, fq * 8);
#define PG8_SA(b, h) (((b) * 2 + (h)) * HTB)
#define PG8_SB(b, h) ((4 + (b) * 2 + (h)) * HTB)
#define PG8_STAGE(bufoff, gbase, voff) do { _Pragma("unroll") for (int _i = 0; _i < 2; ++_i) \
        __builtin_amdgcn_global_load_lds((const unsigned*)((const char*)(gbase) + (voff)[_i]), (PG8_LAS unsigned*)(lds + (bufoff) + ldsw + _i * 8192), 16, 0, 0); } while (0)
#define PG8_LDA(dst, b, h) do { _Pragma("unroll") for (int m = 0; m < 4; ++m) _Pragma("unroll") for (int k = 0; k < 2; ++k) dst[m][k] = *(const PG8_LAS bf16x8*)(lds + PG8_SA(b, h) + aoff + m * 2048 + k * 1024); } while (0)
#define PG8_LDB(dst, b, h) do { _Pragma("unroll") for (int n = 0; n < 2; ++n) _Pragma("unroll") for (int k = 0; k < 2; ++k) dst[n][k] = *(const PG8_LAS bf16x8*)(lds + PG8_SB(b, h) + boff + n * 2048 + k * 1024); } while (0)
#define PG8_MMA(ai, bj, At, Bt) do { __builtin_amdgcn_s_setprio(1); _Pragma("unroll") for (int m = 0; m < 4; ++m) _Pragma("unroll") for (int n = 0; n < 2; ++n) _Pragma("unroll") for (int k = 0; k < 2; ++k) \
        acc[ai][bj][m][n] = __builtin_amdgcn_mfma_f32_16x16x32_bf16(Bt[n][k], At[m][k], acc[ai][bj][m][n], 0, 0, 0); __builtin_amdgcn_s_setprio(0); } while (0)
#define PG8_WAIT_V(n) asm volatile("s_waitcnt vmcnt(" #n ")" ::: "memory")
#define PG8_WAIT_L(n) asm volatile("s_waitcnt lgkmcnt(" #n ")" ::: "memory")
#define PG8_BAR __builtin_amdgcn_s_barrier()
#define PG8_SCHED __builtin_amdgcn_sched_barrier(0)
    Unit cur, nxt; int ui = 0;
    if (!S.next(0, cur)) return;
    f32x4 acc[2][2][4][2];
#pragma unroll
    for (int a = 0; a < 2; ++a)
#pragma unroll
        for (int b = 0; b < 2; ++b)
#pragma unroll
            for (int m = 0; m < 4; ++m)
#pragma unroll
                for (int n = 0; n < 2; ++n) acc[a][b][m][n] = (f32x4){0.f, 0.f, 0.f, 0.f};
    bf16x8 At[4][2], B0[2][2], B1[2][2];
    const char* cA = (const char*)g.A + (size_t)cur.pm * tstepA; const char* cB = (const char*)g.Bt + (size_t)cur.pn * tstepB;
    S.a_ready(cur);
    if constexpr (SP2) {
        PG8_STAGE(PG8_SB(0, 0), cB, voffB); PG8_STAGE(PG8_SB(0, 1), cB + hstepB, voffB); PG8_STAGE(PG8_SA(0, 0), cA, voffA); PG8_STAGE(PG8_SA(0, 1), cA + hstepA, voffA);
        if (wr == 1) PG8_BAR;
        PG8_WAIT_V(2); PG8_BAR;
        PG8_STAGE(PG8_SB(1, 0), cB + kstep, voffB); PG8_STAGE(PG8_SA(1, 0), cA + kstep, voffA); PG8_STAGE(PG8_SB(1, 1), cB + hstepB + kstep, voffB);
        PG8_WAIT_V(6); PG8_BAR;
    } else {
        PG8_STAGE(PG8_SB(0, 0), cB, voffB); PG8_STAGE(PG8_SA(0, 0), cA, voffA); PG8_STAGE(PG8_SB(0, 1), cB + hstepB, voffB); PG8_STAGE(PG8_SA(0, 1), cA + hstepA, voffA);
        if (wr == 1) PG8_BAR;
        PG8_WAIT_V(4); PG8_BAR;
        PG8_STAGE(PG8_SB(1, 0), cB + kstep, voffB); PG8_STAGE(PG8_SA(1, 0), cA + kstep, voffA); PG8_STAGE(PG8_SB(1, 1), cB + hstepB + kstep, voffB);
        PG8_WAIT_V(6); PG8_BAR;
    }
    for (;;) {
        const bool has_next = S.next(ui + 1, nxt);
        const char* nA = has_next ? (const char*)g.A + (size_t)nxt.pm * tstepA : cA; const char* nB = has_next ? (const char*)g.Bt + (size_t)nxt.pn * tstepB : cB;
        for (int t = 0; t < nt; t += 2) {
            if constexpr (Epi::MID) { if (t == (nt >> 1)) E.mid(acc, cur, wr, wc, fr, fq); }
            const bool last = (t == nt - 2);
            const char* a1 = cA + (size_t)(t + 1) * kstep;
            const char* a2 = last ? nA : cA + (size_t)(t + 2) * kstep; const char* b2 = last ? nB : cB + (size_t)(t + 2) * kstep;
            const char* a3 = a2 + kstep; const char* b3 = b2 + kstep;
            if (last && has_next) S.a_ready(nxt);
            if constexpr (SP2) {
            PG8_LDB(B0, 0, 0); PG8_LDB(B1, 0, 1); PG8_SCHED; PG8_LDA(At, 0, 0); PG8_STAGE(PG8_SA(1, 1), a1 + hstepA, voffA);
            PG8_WAIT_V(8); PG8_WAIT_L(0); PG8_BAR; PG8_MMA(0, 0, At, B0); PG8_MMA(0, 1, At, B1); PG8_BAR; PG8_SCHED;
            PG8_LDA(At, 0, 1); PG8_STAGE(PG8_SB(0, 0), b2, voffB); PG8_STAGE(PG8_SB(0, 1), b2 + hstepB, voffB); PG8_STAGE(PG8_SA(0, 0), a2, voffA);
            PG8_WAIT_V(8); PG8_WAIT_L(0); PG8_BAR; PG8_MMA(1, 0, At, B0); PG8_MMA(1, 1, At, B1); PG8_BAR; PG8_SCHED;
            PG8_LDB(B0, 1, 0); PG8_LDB(B1, 1, 1); PG8_SCHED; PG8_LDA(At, 1, 0); PG8_STAGE(PG8_SA(0, 1), a2 + hstepA, voffA);
            PG8_WAIT_V(8); PG8_WAIT_L(0); PG8_BAR; PG8_MMA(0, 0, At, B0); PG8_MMA(0, 1, At, B1); PG8_BAR; PG8_SCHED;
            PG8_LDA(At, 1, 1); PG8_STAGE(PG8_SB(1, 0), b3, voffB); PG8_STAGE(PG8_SB(1, 1), b3 + hstepB, voffB); PG8_STAGE(PG8_SA(1, 0), a3, voffA);
            PG8_WAIT_V(8); PG8_WAIT_L(0); PG8_BAR; PG8_MMA(1, 0, At, B0); PG8_MMA(1, 1, At, B1); PG8_BAR; PG8_SCHED;
            } else {
            PG8_LDB(B0, 0, 0); PG8_SCHED; PG8_LDA(At, 0, 0); PG8_STAGE(PG8_SA(1, 1), a1 + hstepA, voffA);
            PG8_WAIT_L(8); PG8_BAR; PG8_WAIT_L(0); PG8_MMA(0, 0, At, B0); PG8_BAR; PG8_SCHED;
            PG8_LDB(B1, 0, 1); PG8_STAGE(PG8_SB(0, 0), b2, voffB);
            PG8_BAR; PG8_WAIT_L(0); PG8_MMA(0, 1, At, B1); PG8_BAR;
            PG8_LDA(At, 0, 1); PG8_STAGE(PG8_SA(0, 0), a2, voffA);
            PG8_BAR; PG8_WAIT_L(0); PG8_MMA(1, 0, At, B0); PG8_BAR; PG8_SCHED;
            PG8_STAGE(PG8_SB(0, 1), b2 + hstepB, voffB);
            PG8_WAIT_V(6); PG8_BAR; PG8_MMA(1, 1, At, B1); PG8_BAR;
            PG8_LDB(B0, 1, 0); PG8_SCHED; PG8_LDA(At, 1, 0); PG8_STAGE(PG8_SA(0, 1), a2 + hstepA, voffA);
            PG8_WAIT_L(8); PG8_BAR; PG8_WAIT_L(0); PG8_MMA(0, 0, At, B0); PG8_BAR; PG8_SCHED;
            PG8_LDB(B1, 1, 1); PG8_STAGE(PG8_SB(1, 0), b3, voffB);
            PG8_BAR; PG8_WAIT_L(0); PG8_MMA(0, 1, At, B1); PG8_BAR;
            PG8_LDA(At, 1, 1); PG8_STAGE(PG8_SA(1, 0), a3, voffA);
            PG8_BAR; PG8_WAIT_L(0); PG8_MMA(1, 0, At, B0); PG8_BAR; PG8_SCHED;
            PG8_STAGE(PG8_SB(1, 1), b3 + hstepB, voffB);
            PG8_WAIT_V(6); PG8_BAR; PG8_MMA(1, 1, At, B1); PG8_BAR;
            }
        }
        if constexpr (ALIGN_EPI) { if (wr == 0) PG8_BAR; }
        if constexpr (!Epi::AFTER_DRAIN) { E(acc, cur, wr, wc, fr, fq); S.done(cur); }
        if (!has_next) break;
#pragma unroll
        for (int a = 0; a < 2; ++a)
#pragma unroll
            for (int b = 0; b < 2; ++b)
#pragma unroll
                for (int m = 0; m < 4; ++m)
#pragma unroll
                    for (int n = 0; n < 2; ++n) acc[a][b][m][n] = (f32x4){0.f, 0.f, 0.f, 0.f};
        cur = nxt; cA = nA; cB = nB; ++ui;
        if constexpr (ALIGN_EPI) { if (wr == 1) PG8_BAR; }
    }
    PG8_WAIT_V(0);
    if constexpr (!ALIGN_EPI) { if (wr == 0) PG8_BAR; }
    PG8_BAR;
    if constexpr (Epi::AFTER_DRAIN) { E.fused(acc, cur, wr, wc, fr, fq, lds, wid, lane); S.done(cur); }
#undef PG8_SA
#undef PG8_SB
#undef PG8_STAGE
#undef PG8_LDA
#undef PG8_LDB
#undef PG8_MMA
#undef PG8_WAIT_V
#undef PG8_WAIT_L
#undef PG8_BAR
#undef PG8_SCHED
}
}

constexpr int BATCH = 8, SEQ = 8192, DM = 1024, T = BATCH * SEQ, DFF = 2816;
constexpr int NIN = 4864;
constexpr float EPS = 1e-6f;
constexpr float QSCALE = 0.07216878364870322f * 1.4426950408889634f;

#define LAS __attribute__((address_space(3)))
typedef unsigned short bf16_t;
typedef short bf16x8 __attribute__((ext_vector_type(8)));
typedef short s16x4 __attribute__((ext_vector_type(4)));
typedef float f32x4 __attribute__((ext_vector_type(4)));
typedef float f32x16 __attribute__((ext_vector_type(16)));
typedef unsigned u32x4 __attribute__((ext_vector_type(4)));
typedef unsigned u32x2 __attribute__((ext_vector_type(2)));

__device__ __forceinline__ float bf2f(bf16_t v) { return __uint_as_float(((unsigned)v) << 16); }
__device__ __forceinline__ unsigned f2bf(float f) { unsigned u = __float_as_uint(f); return (u + 0x7fffu + ((u >> 16) & 1u)) >> 16; }
__device__ __forceinline__ unsigned pk2(float lo, float hi) { return pg8::cvt_pk_bf16(lo, hi); }
__device__ __forceinline__ float fast_rcp(float x) { return __builtin_amdgcn_rcpf(x); }
__device__ __forceinline__ float silu_f(float x) { return x * fast_rcp(1.0f + __expf(-x)); }
__device__ __forceinline__ float sigmoid_f(float x) { return fast_rcp(1.0f + __expf(-x)); }
__device__ __forceinline__ float wave_sum(float v) {
#pragma unroll
    for (int o = 1; o < 64; o <<= 1) v += __shfl_xor(v, o);
    return v;
}

#define LDS_BARRIER() do { asm volatile("s_waitcnt lgkmcnt(0)" ::: "memory"); __builtin_amdgcn_s_barrier(); asm volatile("" ::: "memory"); } while (0)
constexpr size_t MiB = 1u << 20;
constexpr size_t WS_SSQ_MIX = 0, WS_SSQ_CQ = 256 * 1024, WS_SSQ_CKV = 512 * 1024, WS_SSQ2 = 768 * 1024;
constexpr size_t WS_W1IN = 2 * MiB;
constexpr size_t WS_W1OUT = WS_W1IN + (size_t)5632 * 1024 * 2;
constexpr size_t WS_WIN = WS_W1OUT + (size_t)1024 * 2816 * 2;
constexpr size_t WS_WMG = WS_WIN + (size_t)NIN * 1024 * 2;
constexpr size_t WS_WQ = WS_WMG + (size_t)2048 * 1024 * 2;
constexpr size_t WS_WKV = WS_WQ + (size_t)1536 * 384 * 2;
constexpr size_t WS_WBR = WS_WKV + (size_t)2048 * 256 * 2;
constexpr size_t WS_WOUT = WS_WBR + (size_t)1024 * 2048 * 2;
constexpr size_t WS_W2IN = WS_WOUT + (size_t)1024 * 1024 * 2;
constexpr size_t WS_W2OUT = WS_W2IN + (size_t)5632 * 1024 * 2;
constexpr size_t WS_WEND = WS_W2OUT + (size_t)1024 * 2816 * 2;
static_assert(WS_WEND <= 60 * MiB, "weights fit");
constexpr size_t WS_SSQO = 60 * MiB;
constexpr size_t WS_R3 = 64 * MiB;
constexpr size_t WS_P = WS_R3, WS_ER = WS_R3 + 32 * MiB, WS_DR = WS_R3 + 40 * MiB;
constexpr size_t WS_IG = 192 * MiB;
constexpr size_t WS_QF = 448 * MiB;
constexpr size_t WS_CQG = 704 * MiB;
constexpr size_t WS_CKVG = 752 * MiB;
constexpr size_t WS_KPE = 784 * MiB;
constexpr size_t WS_KF = 792 * MiB;
constexpr size_t WS_HID = 192 * MiB;
constexpr size_t WS_NEED = 984 * MiB;

constexpr int LDS_BYTES = 147456;

struct Params {
    const float* in[24];
    float* out;
    unsigned char* ws;
};

typedef const f32x4 (&AccRef)[2][2][4][2];

struct EpiSwiglu {
    static constexpr bool PERM = true, AFTER_DRAIN = false, MID = false;
    bf16_t* O; const float* ssq;
    __device__ __forceinline__ void mid(f32x4 (&)[2][2][4][2], const pg8::Unit&, int, int, int, int) const {}
    __device__ __forceinline__ void operator()(AccRef acc, const pg8::Unit& u, int wr, int wc, int fr, int fq) const {
        const int col = u.pn * 128 + wc * 32 + 8 * fq;
#pragma unroll
        for (int ai = 0; ai < 2; ++ai)
#pragma unroll
            for (int m = 0; m < 4; ++m) {
                const int row = u.pm * 256 + ai * 128 + wr * 64 + m * 16 + fr;
                const float s = ssq ? rsqrtf(ssq[row] * (1.0f / 1024.0f) + EPS) : 1.0f;
                float h[8];
#pragma unroll
                for (int n = 0; n < 2; ++n)
#pragma unroll
                    for (int j = 0; j < 4; ++j) { const float g = acc[ai][0][m][n][j] * s, up = acc[ai][1][m][n][j] * s; h[n * 4 + j] = silu_f(g) * up; }
                u32x4 w; w.x = pk2(h[0], h[1]); w.y = pk2(h[2], h[3]); w.z = pk2(h[4], h[5]); w.w = pk2(h[6], h[7]);
                *(u32x4*)(O + (size_t)row * DFF + col) = w;
            }
    }
};

template <class TB, class TO, int COEF2> struct EpiRes {
    static constexpr bool PERM = true, AFTER_DRAIN = false, MID = false;
    static constexpr bool BASE_BF16 = sizeof(TB) == 2, OUT_BF16 = sizeof(TO) == 2;
    static constexpr float coef = 0.5f * COEF2;
    const TB* base; TO* out; bf16_t* og; const float* gain; float* ssq;
    __device__ __forceinline__ void mid(f32x4 (&)[2][2][4][2], const pg8::Unit&, int, int, int, int) const {}
    __device__ __forceinline__ void operator()(AccRef acc, const pg8::Unit& u, int wr, int wc, int fr, int fq) const {
        const int col0 = u.pn * 256 + wc * 32 + 8 * fq;
        f32x4 gv[2][2];
#pragma unroll
        for (int bj = 0; bj < 2; ++bj)
#pragma unroll
            for (int n = 0; n < 2; ++n) gv[bj][n] = og ? *(const f32x4*)(gain + col0 + bj * 128 + 4 * n) : (f32x4){0.f, 0.f, 0.f, 0.f};
#pragma unroll
        for (int ai = 0; ai < 2; ++ai)
#pragma unroll
            for (int m = 0; m < 4; ++m) {
                const int row = u.pm * 256 + ai * 128 + wr * 64 + m * 16 + fr;
                float sq = 0.f;
#pragma unroll
                for (int bj = 0; bj < 2; ++bj) {
                    const size_t off = (size_t)row * DM + col0 + bj * 128;
                    f32x4 b0, b1;
                    if (BASE_BF16) { const u32x4 bb = *(const u32x4*)((const bf16_t*)base + off);
                        b0 = (f32x4){__uint_as_float(bb.x << 16), __uint_as_float(bb.x & 0xffff0000u), __uint_as_float(bb.y << 16), __uint_as_float(bb.y & 0xffff0000u)};
                        b1 = (f32x4){__uint_as_float(bb.z << 16), __uint_as_float(bb.z & 0xffff0000u), __uint_as_float(bb.w << 16), __uint_as_float(bb.w & 0xffff0000u)}; }
                    else { b0 = *(const f32x4*)((const float*)base + off); b1 = *(const f32x4*)((const float*)base + off + 4); }
                    const f32x4 o0 = b0 + acc[ai][bj][m][0] * coef, o1 = b1 + acc[ai][bj][m][1] * coef;
                    if (OUT_BF16) { u32x4 w; w.x = pk2(o0[0], o0[1]); w.y = pk2(o0[2], o0[3]); w.z = pk2(o1[0], o1[1]); w.w = pk2(o1[2], o1[3]); *(u32x4*)((bf16_t*)out + off) = w; }
                    else { *(f32x4*)((float*)out + off) = o0; *(f32x4*)((float*)out + off + 4) = o1; }
                    sq += (o0[0] * o0[0] + o0[1] * o0[1]) + (o0[2] * o0[2] + o0[3] * o0[3]) + (o1[0] * o1[0] + o1[1] * o1[1]) + (o1[2] * o1[2] + o1[3] * o1[3]);
                    if (og) { const f32x4 y0 = o0 * gv[bj][0], y1 = o1 * gv[bj][1];
                        u32x4 w; w.x = pk2(y0[0], y0[1]); w.y = pk2(y0[2], y0[3]); w.z = pk2(y1[0], y1[1]); w.w = pk2(y1[2], y1[3]);
                        *(u32x4*)(og + off) = w; }
                }
                if (ssq) { sq += __shfl_xor(sq, 16); sq += __shfl_xor(sq, 32); if (fq == 0) atomicAdd(ssq + row, sq); }
            }
    }
};

struct EpiIn {
    static constexpr bool PERM = true, AFTER_DRAIN = false, MID = false;
    bf16_t *QF, *IG, *cqg, *ckvg, *kpe; const float* ssq_mix; float *ssq_cq, *ssq_ckv; const float *gq, *gkv;
    __device__ __forceinline__ void mid(f32x4 (&)[2][2][4][2], const pg8::Unit&, int, int, int, int) const {}
    __device__ __forceinline__ void operator()(AccRef acc, const pg8::Unit& u, int wr, int wc, int fr, int fq) const {
        float sr[2][4];
#pragma unroll
        for (int ai = 0; ai < 2; ++ai)
#pragma unroll
            for (int m = 0; m < 4; ++m) sr[ai][m] = rsqrtf(ssq_mix[u.pm * 256 + ai * 128 + wr * 64 + m * 16 + fr] * (1.0f / 1024.0f) + EPS);
#pragma unroll
        for (int bj = 0; bj < 2; ++bj) {
            const int c0 = u.pn * 256 + bj * 128, cc = c0 + wc * 32 + 8 * fq;
            bf16_t* dst; int ld; const float* gain = nullptr; float* ssq = nullptr;
            if (c0 < 2048) { dst = QF + cc; ld = 2048; }
            else if (c0 < 4096) { dst = IG + (cc - 2048); ld = 2048; }
            else if (c0 < 4480) { dst = cqg + (cc - 4096); ld = 384; gain = gq + (cc - 4096); ssq = ssq_cq; }
            else if (c0 < 4736) { dst = ckvg + (cc - 4480); ld = 256; gain = gkv + (cc - 4480); ssq = ssq_ckv; }
            else { if (wc >= 2) continue; dst = kpe + (cc - 4736); ld = 64; }
            f32x4 g0 = (f32x4){1.f, 1.f, 1.f, 1.f}, g1 = g0;
            if (gain) { g0 = *(const f32x4*)gain; g1 = *(const f32x4*)(gain + 4); }
#pragma unroll
            for (int ai = 0; ai < 2; ++ai)
#pragma unroll
                for (int m = 0; m < 4; ++m) {
                    const int row = u.pm * 256 + ai * 128 + wr * 64 + m * 16 + fr;
                    const f32x4 v0 = acc[ai][bj][m][0] * sr[ai][m], v1 = acc[ai][bj][m][1] * sr[ai][m];
                    if (ssq) { float sq = (v0[0] * v0[0] + v0[1] * v0[1]) + (v0[2] * v0[2] + v0[3] * v0[3]) + (v1[0] * v1[0] + v1[1] * v1[1]) + (v1[2] * v1[2] + v1[3] * v1[3]);
                        sq += __shfl_xor(sq, 16); sq += __shfl_xor(sq, 32); if (fq == 0) atomicAdd(ssq + row, sq); }
                    const f32x4 y0 = v0 * g0, y1 = v1 * g1;
                    u32x4 w; w.x = pk2(y0[0], y0[1]); w.y = pk2(y0[2], y0[3]); w.z = pk2(y1[0], y1[1]); w.w = pk2(y1[2], y1[3]);
                    *(u32x4*)(dst + (size_t)row * ld) = w;
                }
        }
    }
};

template <int ldc, int hs> struct EpiPlain {
    static constexpr bool PERM = true, AFTER_DRAIN = false, MID = false;
    bf16_t* O;
    __device__ __forceinline__ void mid(f32x4 (&)[2][2][4][2], const pg8::Unit&, int, int, int, int) const {}
    __device__ __forceinline__ void operator()(AccRef acc, const pg8::Unit& u, int wr, int wc, int fr, int fq) const {
#pragma unroll
        for (int ai = 0; ai < 2; ++ai)
#pragma unroll
            for (int m = 0; m < 4; ++m) {
                const int row = u.pm * 256 + ai * 128 + wr * 64 + m * 16 + fr;
#pragma unroll
                for (int bj = 0; bj < 2; ++bj) {
                    const int col = (u.pn * 2 + bj) * hs + wc * 32 + 8 * fq;
                    const f32x4 y0 = acc[ai][bj][m][0], y1 = acc[ai][bj][m][1];
                    u32x4 w; w.x = pk2(y0[0], y0[1]); w.y = pk2(y0[2], y0[3]); w.z = pk2(y1[0], y1[1]); w.w = pk2(y1[2], y1[3]);
                    *(u32x4*)(O + (size_t)row * ldc + col) = w;
                }
            }
    }
};

struct EpiGate {
    static constexpr bool PERM = true, AFTER_DRAIN = false, MID = false;
    bf16_t* G; const float* ssq_mix; const float* bias;
    __device__ __forceinline__ void mid(f32x4 (&)[2][2][4][2], const pg8::Unit&, int, int, int, int) const {}
    __device__ __forceinline__ void operator()(AccRef acc, const pg8::Unit& u, int wr, int wc, int fr, int fq) const {
        const int col0 = u.pn * 256 + wc * 32 + 8 * fq;
        f32x4 bv[2][2];
#pragma unroll
        for (int bj = 0; bj < 2; ++bj)
#pragma unroll
            for (int n = 0; n < 2; ++n) bv[bj][n] = *(const f32x4*)(bias + col0 + bj * 128 + 4 * n);
#pragma unroll
        for (int ai = 0; ai < 2; ++ai)
#pragma unroll
            for (int m = 0; m < 4; ++m) {
                const int row = u.pm * 256 + ai * 128 + wr * 64 + m * 16 + fr;
                const float s = rsqrtf(ssq_mix[row] * (1.0f / 1024.0f) + EPS);
#pragma unroll
                for (int bj = 0; bj < 2; ++bj) {
                    const f32x4 a0 = acc[ai][bj][m][0] * s + bv[bj][0], a1 = acc[ai][bj][m][1] * s + bv[bj][1];
                    u32x4 w; w.x = pk2(sigmoid_f(a0[0]), sigmoid_f(a0[1])); w.y = pk2(sigmoid_f(a0[2]), sigmoid_f(a0[3]));
                    w.z = pk2(sigmoid_f(a1[0]), sigmoid_f(a1[1])); w.w = pk2(sigmoid_f(a1[2]), sigmoid_f(a1[3]));
                    *(u32x4*)(G + (size_t)row * 2048 + col0 + bj * 128) = w;
                }
            }
    }
};

template <bool SECOND> struct EpiBranch {
    static constexpr bool PERM = true, AFTER_DRAIN = false, MID = false;
    const bf16_t* G; int gcol0; bf16_t* tmp; bf16_t* O;
    __device__ __forceinline__ void mid(f32x4 (&)[2][2][4][2], const pg8::Unit&, int, int, int, int) const {}
    __device__ __forceinline__ void operator()(AccRef acc, const pg8::Unit& u, int wr, int wc, int fr, int fq) const {
        const int col0 = u.pn * 256 + wc * 32 + 8 * fq;
#pragma unroll
        for (int ai = 0; ai < 2; ++ai)
#pragma unroll
            for (int m = 0; m < 4; ++m) {
                const int row = u.pm * 256 + ai * 128 + wr * 64 + m * 16 + fr;
#pragma unroll
                for (int bj = 0; bj < 2; ++bj) {
                    const u32x4 gh = *(const u32x4*)(G + (size_t)row * 2048 + gcol0 + col0 + bj * 128);
                    u32x4 tv = (u32x4){0u, 0u, 0u, 0u};
                    if (SECOND) tv = *(const u32x4*)(tmp + (size_t)row * DM + col0 + bj * 128);
                    float y[8];
#pragma unroll
                    for (int q = 0; q < 4; ++q) {
                        const float h0 = __uint_as_float(gh[q] << 16), h1 = __uint_as_float(gh[q] & 0xffff0000u);
                        const float t0 = __uint_as_float(tv[q] << 16), t1 = __uint_as_float(tv[q] & 0xffff0000u);
                        const int n = q >> 1, j = (q & 1) * 2;
                        y[2 * q] = acc[ai][bj][m][n][j] * h0 + t0; y[2 * q + 1] = acc[ai][bj][m][n][j + 1] * h1 + t1;
                    }
                    u32x4 w; w.x = pk2(y[0], y[1]); w.y = pk2(y[2], y[3]); w.z = pk2(y[4], y[5]); w.w = pk2(y[6], y[7]);
                    *(u32x4*)((SECOND ? O : tmp) + (size_t)row * DM + col0 + bj * 128) = w;
                }
            }
    }
};

template <class Epi, bool ALIGN = true>
__device__ __forceinline__ void run_gemm(LAS unsigned char* lds, const bf16_t* A, const bf16_t* Bt, int M, int N, int K, const Epi& E, int G, int c, int lda = 0, int ldb = 0) {
    pg8::Gemm g{A, Bt, M, N, K, lda ? lda : K, ldb ? ldb : K}; pg8::StaticOrder S; S.init(M, N, G, c);
    pg8::gemm_phase<Epi, pg8::StaticOrder, ALIGN, true>(lds, g, S, E);
}

typedef __attribute__((address_space(4))) const unsigned char* karg_ptr_t;
__device__ __forceinline__ const float* karg_in(int i) { karg_ptr_t kp = (karg_ptr_t)__builtin_amdgcn_kernarg_segment_ptr(); asm volatile("" : "+s"(kp)); return *(const float* __attribute__((address_space(4))) const*)(kp + 8 * i); }
__device__ __forceinline__ float* karg_out() { karg_ptr_t kp = (karg_ptr_t)__builtin_amdgcn_kernarg_segment_ptr(); asm volatile("" : "+s"(kp)); return *(float* __attribute__((address_space(4))) const*)(kp + 8 * 24); }
__device__ __forceinline__ unsigned char* karg_ws() { karg_ptr_t kp = (karg_ptr_t)__builtin_amdgcn_kernarg_segment_ptr(); asm volatile("" : "+s"(kp)); return *(unsigned char* __attribute__((address_space(4))) const*)(kp + 8 * 25); }
__device__ __forceinline__ int tr_map(int mode, int n) {
    if (mode == 0) return n;
    if (mode == 1) { if (n < DFF) return 256 * (n >> 7) + (n & 127); const int n2 = n - DFF; return 256 * (n2 >> 7) + 128 + (n2 & 127); }
    const int h = n >> 8, j = n & 255; return ((j < 128) ? 0 : 1024) + h * 128 + (j & 127);
}
__device__ __forceinline__ void tr_item(const float* W, int K, int N, bf16_t* WT, int ldk, int koff, int mode, LAS float* scr, int item, int lane) {
    const int nblk = N / 32, kb = item / nblk, nb = item % nblk, k0 = 64 * kb, n0 = 32 * nb;
#pragma unroll 8
    for (int i = 0; i < 32; ++i) { const int kk = 2 * i + (lane >> 5); scr[kk * 33 + (lane & 31)] = W[(size_t)(k0 + kk) * N + n0 + (lane & 31)]; }
    asm volatile("s_waitcnt lgkmcnt(0)" ::: "memory");
    const int c = lane & 7;
#pragma unroll
    for (int j = 0; j < 4; ++j) { const int n = (lane >> 3) + 8 * j; const LAS float* s = scr + (8 * c) * 33 + n;
        u32x4 o; o.x = f2bf(s[0 * 33]) | (f2bf(s[1 * 33]) << 16); o.y = f2bf(s[2 * 33]) | (f2bf(s[3 * 33]) << 16); o.z = f2bf(s[4 * 33]) | (f2bf(s[5 * 33]) << 16); o.w = f2bf(s[6 * 33]) | (f2bf(s[7 * 33]) << 16);
        *(u32x4*)(WT + (size_t)tr_map(mode, n0 + n) * ldk + koff + k0 + 8 * c) = o; }
    asm volatile("s_waitcnt lgkmcnt(0)" ::: "memory");
}
__device__ __forceinline__ void row_to_bf16(const float* xrow, const float* gain, bf16_t* orow, bool norm, int lane) {
    const f32x4* xr = (const f32x4*)xrow + lane; const f32x4* gr = (const f32x4*)gain + lane;
    f32x4 v[4]; float s = 0.f;
#pragma unroll
    for (int j = 0; j < 4; ++j) { v[j] = xr[64 * j]; s += (v[j].x * v[j].x + v[j].y * v[j].y) + (v[j].z * v[j].z + v[j].w * v[j].w); }
    float r = 1.0f;
    if (norm) r = rsqrtf(wave_sum(s) * (1.0f / DM) + EPS);
    u32x2* o8 = (u32x2*)orow + lane;
#pragma unroll
    for (int j = 0; j < 4; ++j) { const f32x4 g = gr[64 * j]; u32x2 w; w.x = pk2(v[j].x * r * g.x, v[j].y * r * g.y); w.y = pk2(v[j].z * r * g.z, v[j].w * r * g.w); o8[64 * j] = w; }
}

__device__ __forceinline__ void prologue(LAS unsigned char* lds, int G, int bid) {
    int tid_l = threadIdx.x; asm volatile("" : "+v"(tid_l));
    const int tid = tid_l, wave = tid >> 6, lane = tid & 63;
    LAS float* scr = (LAS float*)(lds + wave * 16384);
    const int gw = bid * 8 + wave, NGW = G * 8;
    { float* z = (float*)(karg_ws() + WS_SSQ_MIX); for (int i = bid * 512 + tid; i < 4 * T; i += G * 512) z[i] = 0.f; }
    { float* z = (float*)(karg_ws() + WS_SSQO); for (int i = bid * 512 + tid; i < 8 * T; i += G * 512) z[i] = 0.f; }
    constexpr int I0 = 16 * 176, I1 = 44 * 32, I2 = 16 * 150, I3 = 16 * 64, I4 = 6 * 48, I5 = 4 * 64, I6 = 16 * 32;
    constexpr int NITEMS = 2 * I0 + 2 * I1 + I2 + I3 + I4 + I5 + 3 * I6;
    for (int it = gw; it < NITEMS; it += NGW) {
        int r = it;
        if (r < I0) { tr_item(karg_in(3), 1024, 5632, (bf16_t*)(karg_ws() + WS_W1IN), 1024, 0, 1, scr, r, lane); continue; } r -= I0;
        if (r < I0) { tr_item(karg_in(21), 1024, 5632, (bf16_t*)(karg_ws() + WS_W2IN), 1024, 0, 1, scr, r, lane); continue; } r -= I0;
        if (r < I1) { tr_item(karg_in(4), 2816, 1024, (bf16_t*)(karg_ws() + WS_W1OUT), 2816, 0, 0, scr, r, lane); continue; } r -= I1;
        if (r < I1) { tr_item(karg_in(22), 2816, 1024, (bf16_t*)(karg_ws() + WS_W2OUT), 2816, 0, 0, scr, r, lane); continue; } r -= I1;
        if (r < I2) { tr_item(karg_in(6), 1024, 4800, (bf16_t*)(karg_ws() + WS_WIN), 1024, 0, 0, scr, r, lane); continue; } r -= I2;
        if (r < I3) { tr_item(karg_in(17), 1024, 2048, (bf16_t*)(karg_ws() + WS_WMG), 1024, 0, 0, scr, r, lane); continue; } r -= I3;
        if (r < I4) { tr_item(karg_in(11), 384, 1536, (bf16_t*)(karg_ws() + WS_WQ), 384, 0, 0, scr, r, lane); continue; } r -= I4;
        if (r < I5) { tr_item(karg_in(13), 256, 2048, (bf16_t*)(karg_ws() + WS_WKV), 256, 0, 2, scr, r, lane); continue; } r -= I5;
        if (r < I6) { tr_item(karg_in(16), 1024, 1024, (bf16_t*)(karg_ws() + WS_WBR), 2048, 0, 0, scr, r, lane); continue; } r -= I6;
        if (r < I6) { tr_item(karg_in(9), 1024, 1024, (bf16_t*)(karg_ws() + WS_WBR), 2048, 1024, 0, scr, r, lane); continue; } r -= I6;
        tr_item(karg_in(19), 1024, 1024, (bf16_t*)(karg_ws() + WS_WOUT), 1024, 0, 0, scr, r, lane);
    }
    bf16_t* u1 = (bf16_t*)(karg_ws() + WS_R3);
    for (int m = gw; m < T; m += NGW) row_to_bf16(karg_in(0) + (size_t)m * DM, karg_in(2), u1 + (size_t)m * DM, true, lane);
}

__device__ __forceinline__ void hg_prepass(LAS unsigned char* lds, bf16_t* QF, const float* lbtab, bf16_t* P, float* Dg, int G, int bid) {
    int tid_l = threadIdx.x; asm volatile("" : "+v"(tid_l));
    const int tid = tid_l, wave = tid >> 6, lane = tid & 63, k = tid & 127, tq = tid >> 7, fr = lane & 15, fq = lane >> 4;
    constexpr int PP_BUF = 2048 + 2 * 32 * 136 * 2;
    bf16_t nqr[8], nfr[8];
    if (bid < 16384) { const int h = bid & 7, bc = bid >> 3; const bf16_t* qp = QF + (size_t)(bc * 32 + 8 * tq) * 2048 + 128 * h + k;
#pragma unroll
        for (int j = 0; j < 8; ++j) { nqr[j] = qp[(size_t)j * 2048]; nfr[j] = qp[(size_t)j * 2048 + 1024]; } }
    int it = 0, hprev = -1; float lb = 0.f, omlb = 0.f;
    for (int u = bid; u < 16384; u += G, ++it) {
        LAS float* seg = (LAS float*)(lds + (it & 1) * PP_BUF);
        LAS bf16_t* Qs = (LAS bf16_t*)(lds + (it & 1) * PP_BUF + 2048);
        LAS bf16_t* Ks = Qs + 32 * 136;
        const int h = u & 7, bc = u >> 3, r0 = bc * 32;
        if (h != hprev) {
            const float t0 = lbtab[128 * h + k], t1 = lbtab[1024 + 128 * h + k], mx = fmaxf(t0, t1);
            const float e0 = __expf(t0 - mx), e1 = __expf(t1 - mx);
            lb = e0 / (e0 + e1); omlb = e1 / (e0 + e1); hprev = h;
        }
        bf16_t* qp = QF + (size_t)(r0 + 8 * tq) * 2048 + 128 * h + k;
        float zq[8], zf[8];
#pragma unroll
        for (int j = 0; j < 8; ++j) { zq[j] = bf2f(nqr[j]); zf[j] = bf2f(nfr[j]); }
        { const int un = u + G;
          if (un < 16384) { const int hn = un & 7, bcn = un >> 3; const bf16_t* qn = QF + (size_t)(bcn * 32 + 8 * tq) * 2048 + 128 * hn + k;
#pragma unroll
              for (int j = 0; j < 8; ++j) { nqr[j] = qn[(size_t)j * 2048]; nfr[j] = qn[(size_t)j * 2048 + 1024]; } } }
        float cl[8], kk[8], qs[8]; float run = 0.f;
#pragma unroll
        for (int j = 0; j < 8; ++j) {
            const float z = zf[j], e = __expf(-z), sg = fast_rcp(1.0f + e);
            const float f = lb + omlb * sg;
            kk[j] = omlb * (e < 3.0e38f ? e * sg : 1.0f);
            run += __logf(f); cl[j] = run;
            qs[j] = silu_f(zq[j]);
        }
        seg[tq * 128 + k] = run;
        LDS_BARRIER();
        const float s0 = seg[k], s1 = seg[128 + k], s2 = seg[256 + k], s3 = seg[384 + k];
        const float prefix = (tq > 0 ? s0 : 0.f) + (tq > 1 ? s1 : 0.f) + (tq > 2 ? s2 : 0.f);
        const float cum_r = s0 + s1, cum_e = cum_r + s2 + s3;
        unsigned kb[8];
        const float Erc = __expf(cum_r), Drc = __expf(cum_e - cum_r);
#pragma unroll
        for (int j = 0; j < 8; ++j) {
            const float d = prefix + cl[j] - cum_r;
            const float E1 = __expf(d), E2 = __expf(-d);
            const float qt = qs[j] * E1, kt = kk[j] * E2;
            qp[(size_t)j * 2048] = (bf16_t)f2bf(qt * Erc);
            kb[j] = f2bf(kt * Drc);
            Qs[(8 * tq + j) * 136 + k] = (bf16_t)f2bf(qt); Ks[(8 * tq + j) * 136 + k] = (bf16_t)f2bf(kt);
        }
        { u32x4 w; w.x = kb[0] | (kb[1] << 16); w.y = kb[2] | (kb[3] << 16); w.z = kb[4] | (kb[5] << 16); w.w = kb[6] | (kb[7] << 16);
          *(u32x4*)(QF + (size_t)(r0 + (k >> 2)) * 2048 + 1024 + 128 * h + (k & 3) * 32 + 8 * tq) = w; }
        if (tq == 0) Dg[(size_t)bc * 1024 + 128 * h + k] = __expf(cum_e);
        LDS_BARRIER();
        if (wave < 3) {
            const int tt = wave > 0 ? 1 : 0, ss = wave == 2 ? 1 : 0;
            f32x4 acc = (f32x4){0.f, 0.f, 0.f, 0.f};
#pragma unroll
            for (int k4 = 0; k4 < 4; ++k4) {
                const bf16x8 a = *(const LAS bf16x8*)(Qs + (16 * tt + fr) * 136 + 32 * k4 + 8 * fq);
                const bf16x8 b = *(const LAS bf16x8*)(Ks + (16 * ss + fr) * 136 + 32 * k4 + 8 * fq);
                acc = __builtin_amdgcn_mfma_f32_16x16x32_bf16(a, b, acc, 0, 0, 0);
            }
#pragma unroll
            for (int i = 0; i < 4; ++i) { const int t = 16 * tt + 4 * fq + i, s = 16 * ss + fr;
                const float v = (s <= t) ? acc[i] : 0.f;
                P[(size_t)u * 1024 + t * 32 + s] = (bf16_t)f2bf(v); }
        }
    }
    LDS_BARRIER();
}

constexpr int H3_QP = 272, H3_KP = 80, H3_PP = 80, H3_VP = 80;
constexpr int H3_Q = 0, H3_K = H3_Q + 32 * H3_QP, H3_P = H3_K + 128 * H3_KP, H3_V = H3_P + 32 * H3_PP, H3_D = H3_V + 32 * H3_VP, H3_STAGE = H3_D + 512;
constexpr int H3_O = 2 * H3_STAGE, H3_OBYTES = 4 * 32 * 32 * 4;
static_assert(H3_O + 2 * H3_OBYTES <= 131072 && H3_STAGE % 16 == 0, "recurrence LDS map");
__device__ __forceinline__ void hg_recur(LAS unsigned char* lds, const bf16_t* QF, bf16_t* IG, const bf16_t* P, const float* Dg, float* ssq_o, int G, int bid) {
    int tid_l = threadIdx.x; asm volatile("" : "+v"(tid_l));
    const int tid = tid_l, w = tid >> 6, lane = tid & 63, lv = lane & 15, fq = lane >> 4, vt = w & 1, kq = w >> 1;
    const int srow = tid >> 4, sch = tid & 15;
    for (int u = bid; u < 256; u += G) {
        const int b = u >> 5, h = (u >> 2) & 7, vq = u & 3;
        f32x4 S[2];
        S[0] = (f32x4){0.f, 0.f, 0.f, 0.f}; S[1] = S[0];
#define H3_FLUSH(cc_, stt_) do { \
            { const LAS float* ot = (const LAS float*)(lds + H3_O + (stt_) * H3_OBYTES) + (tid >> 4) * 32 + 2 * (tid & 15); \
              typedef float f32x2v __attribute__((ext_vector_type(2))); \
              const f32x2v p0 = *(const LAS f32x2v*)ot, p1 = *(const LAS f32x2v*)(ot + 1024), p2 = *(const LAS f32x2v*)(ot + 2048), p3 = *(const LAS f32x2v*)(ot + 3072); \
              const float x0 = (p0.x + p1.x) + (p2.x + p3.x), x1 = (p0.y + p1.y) + (p2.y + p3.y); \
              const size_t row = (size_t)(b * 256 + (cc_)) * 32 + (tid >> 4); \
              *(unsigned*)(IG + row * 2048 + 128 * h + 32 * vq + 2 * (tid & 15)) = pk2(x0, x1); \
              float sq = x0 * x0 + x1 * x1; \
              sq += __builtin_bit_cast(float, __builtin_amdgcn_update_dpp(0, __builtin_bit_cast(int, sq), 0x128, 0xf, 0xf, true)); \
              sq += __builtin_bit_cast(float, __builtin_amdgcn_update_dpp(0, __builtin_bit_cast(int, sq), 0x124, 0xf, 0xf, true)); \
              sq += __builtin_bit_cast(float, __builtin_amdgcn_update_dpp(0, __builtin_bit_cast(int, sq), 0x122, 0xf, 0xf, true)); \
              sq += __builtin_bit_cast(float, __builtin_amdgcn_update_dpp(0, __builtin_bit_cast(int, sq), 0x121, 0xf, 0xf, true)); \
              if ((tid & 15) == 0) atomicAdd(ssq_o + row * 8 + h, sq); } } while (0)
        u32x4 rqA, rkA, rxA, rqB, rkB, rxB;
#define H3_GLOAD(X, c_) do { const int bc_ = b * 256 + (c_); const size_t ro_ = (size_t)(bc_ * 32 + srow) * 2048 + 128 * h + 8 * sch; \
            rq##X = *(const u32x4*)(QF + ro_); rk##X = *(const u32x4*)(QF + ro_ + 1024); \
            if (tid < 128) rx##X = *(const u32x4*)(P + ((size_t)bc_ * 8 + h) * 1024 + 8 * tid); \
            else if (tid < 256) rx##X = *(const u32x4*)(IG + (size_t)(bc_ * 32 + ((tid - 128) >> 2)) * 2048 + 128 * h + 32 * vq + 8 * (tid & 3)); \
            else if (tid < 288) rx##X = *(const u32x4*)(Dg + (size_t)bc_ * 1024 + 128 * h + 4 * (tid - 256)); } while (0)
#define H3_LSTORE(X, st_) do { LAS unsigned char* sb_ = lds + (st_) * H3_STAGE; \
            *(LAS u32x4*)(sb_ + H3_Q + srow * H3_QP + sch * 16) = rq##X; \
            *(LAS u32x4*)(sb_ + H3_K + (4 * srow + (sch >> 2)) * H3_KP + (sch & 3) * 16) = rk##X; \
            if (tid < 128) *(LAS u32x4*)(sb_ + H3_P + (tid >> 2) * H3_PP + (tid & 3) * 16) = rx##X; \
            else if (tid < 256) *(LAS u32x4*)(sb_ + H3_V + ((tid - 128) >> 2) * H3_VP + (tid & 3) * 16) = rx##X; \
            else if (tid < 288) *(LAS u32x4*)(sb_ + H3_D + (tid - 256) * 16) = rx##X; } while (0)
        H3_GLOAD(A, 0);
        H3_GLOAD(B, 1);
        H3_LSTORE(A, 0);
        LDS_BARRIER();
        for (int c2 = 0; c2 < 256; c2 += 2) {
#pragma unroll
          for (int par = 0; par < 2; ++par) {
            const int c = c2 + par, st = par;
            if (c + 1 < 256) { if (par == 0) H3_LSTORE(B, 1); else H3_LSTORE(A, 0); }
            if (c + 2 < 256) { if (par == 0) H3_GLOAD(A, c + 2); else H3_GLOAD(B, c + 2); }
            LAS unsigned char* sb = lds + st * H3_STAGE;
            u32x2 vfu[2];
#pragma unroll
            for (int ss = 0; ss < 2; ++ss) {
                const LAS unsigned char* vp = sb + H3_V + (16 * ss + 4 * fq) * H3_VP + (16 * vt + lv) * 2;
                const unsigned e0 = *(const LAS bf16_t*)(vp), e1 = *(const LAS bf16_t*)(vp + H3_VP), e2 = *(const LAS bf16_t*)(vp + 2 * H3_VP), e3 = *(const LAS bf16_t*)(vp + 3 * H3_VP);
                vfu[ss].x = e0 | (e1 << 16); vfu[ss].y = e2 | (e3 << 16);
            }
            const s16x4 vf0 = __builtin_bit_cast(s16x4, vfu[0]), vf1 = __builtin_bit_cast(s16x4, vfu[1]);
            if (c > 0) H3_FLUSH(c - 1, st ^ 1);
            f32x4 o0 = (f32x4){0.f, 0.f, 0.f, 0.f}, o1 = o0;
#pragma unroll
            for (int k2 = 0; k2 < 2; ++k2) {
                u32x2 sbu; sbu.x = pk2(S[k2][0], S[k2][1]); sbu.y = pk2(S[k2][2], S[k2][3]);
                const s16x4 Sb = __builtin_bit_cast(s16x4, sbu);
                const LAS unsigned char* qp = sb + H3_Q + lv * H3_QP + (32 * kq + 16 * k2 + 4 * fq) * 2;
                const s16x4 a0 = *(const LAS s16x4*)qp, a1 = *(const LAS s16x4*)(qp + 16 * H3_QP);
                o0 = __builtin_amdgcn_mfma_f32_16x16x16bf16_1k(a0, Sb, o0, 0, 0, 0);
                o1 = __builtin_amdgcn_mfma_f32_16x16x16bf16_1k(a1, Sb, o1, 0, 0, 0);
            }
            if (kq < 3) {
                const LAS unsigned char* pp = sb + H3_P + (16 * (kq > 0 ? 1 : 0) + lv) * H3_PP + (16 * (kq == 2 ? 1 : 0) + 4 * fq) * 2;
                const s16x4 a = *(const LAS s16x4*)pp;
                if (kq == 0) o0 = __builtin_amdgcn_mfma_f32_16x16x16bf16_1k(a, vf0, o0, 0, 0, 0);
                else if (kq == 1) o1 = __builtin_amdgcn_mfma_f32_16x16x16bf16_1k(a, vf0, o1, 0, 0, 0);
                else o1 = __builtin_amdgcn_mfma_f32_16x16x16bf16_1k(a, vf1, o1, 0, 0, 0);
            }
#pragma unroll
            for (int k2 = 0; k2 < 2; ++k2) {
                const f32x4 dd = *(const LAS f32x4*)(sb + H3_D + (32 * kq + 16 * k2 + 4 * fq) * 4);
                S[k2] = S[k2] * dd;
                const LAS unsigned char* kp = sb + H3_K + (32 * kq + 16 * k2 + lv) * H3_KP + 4 * fq * 2;
                const s16x4 a0 = *(const LAS s16x4*)kp, a1 = *(const LAS s16x4*)(kp + 32);
                S[k2] = __builtin_amdgcn_mfma_f32_16x16x16bf16_1k(a0, vf0, S[k2], 0, 0, 0);
                S[k2] = __builtin_amdgcn_mfma_f32_16x16x16bf16_1k(a1, vf1, S[k2], 0, 0, 0);
            }
            { LAS float* ot = (LAS float*)(lds + H3_O + st * H3_OBYTES) + kq * 1024 + 16 * vt + lv;
#pragma unroll
              for (int i = 0; i < 4; ++i) { ot[(4 * fq + i) * 32] = o0[i]; ot[(16 + 4 * fq + i) * 32] = o1[i]; } }
            LDS_BARRIER();
          }
        }
        H3_FLUSH(255, 1);
#undef H3_FLUSH
#undef H3_GLOAD
#undef H3_LSTORE
        LDS_BARRIER();
    }
}

__device__ __forceinline__ void hg_norm_pass(bf16_t* IG, const float* ssq_o, const float* gain, int G, int bid) {
    int tid_l = threadIdx.x; asm volatile("" : "+v"(tid_l));
    const int tid = tid_l, wave = tid >> 6, lane = tid & 63, gw = bid * 8 + wave, NGW = G * 8;
    float gv[16];
#pragma unroll
    for (int j = 0; j < 16; ++j) gv[j] = gain[((16 * lane) & 127) + j];
    for (int row = gw; row < T; row += NGW) {
        bf16_t* rp = IG + (size_t)row * 2048 + 16 * lane;
        const u32x4 a0 = *(const u32x4*)rp, a1 = *(const u32x4*)(rp + 8), g0 = *(const u32x4*)(rp + 1024), g1 = *(const u32x4*)(rp + 1032);
        const float r = rsqrtf(ssq_o[(size_t)row * 8 + (lane >> 3)] * (1.0f / 128.0f) + EPS);
        u32x4 w0, w1;
#pragma unroll
        for (int q = 0; q < 4; ++q) {
            const float x0 = __uint_as_float(a0[q] << 16), x1 = __uint_as_float(a0[q] & 0xffff0000u), y0 = __uint_as_float(a1[q] << 16), y1 = __uint_as_float(a1[q] & 0xffff0000u);
            const float s0 = silu_f(__uint_as_float(g0[q] << 16)), s1 = silu_f(__uint_as_float(g0[q] & 0xffff0000u)), t0 = silu_f(__uint_as_float(g1[q] << 16)), t1 = silu_f(__uint_as_float(g1[q] & 0xffff0000u));
            w0[q] = pk2(x0 * r * gv[2 * q] * s0, x1 * r * gv[2 * q + 1] * s1);
            w1[q] = pk2(y0 * r * gv[8 + 2 * q] * t0, y1 * r * gv[8 + 2 * q + 1] * t1);
        }
        *(u32x4*)(rp + 1024) = w0; *(u32x4*)(rp + 1032) = w1;
    }
}

__device__ __forceinline__ void fin_head(const u32x4 a0, const u32x4 a1, const u32x2 r1, const u32x2 r2, const float (&gn)[16], const float (&g1)[4], const float (&g2)[4],
                                         const float (&sn)[4], const float (&cs)[4], float scale, u32x4& o0, u32x4& o1, u32x2& q1, u32x2& q2) {
    float v[16], x1[4], x2[4];
#pragma unroll
    for (int q = 0; q < 4; ++q) { v[2 * q] = __uint_as_float(a0[q] << 16); v[2 * q + 1] = __uint_as_float(a0[q] & 0xffff0000u); v[8 + 2 * q] = __uint_as_float(a1[q] << 16); v[8 + 2 * q + 1] = __uint_as_float(a1[q] & 0xffff0000u); }
#pragma unroll
    for (int q = 0; q < 2; ++q) { x1[2 * q] = __uint_as_float(r1[q] << 16); x1[2 * q + 1] = __uint_as_float(r1[q] & 0xffff0000u); x2[2 * q] = __uint_as_float(r2[q] << 16); x2[2 * q + 1] = __uint_as_float(r2[q] & 0xffff0000u); }
    float ss = 0.f;
#pragma unroll
    for (int j = 0; j < 16; ++j) ss += v[j] * v[j];
#pragma unroll
    for (int j = 0; j < 4; ++j) ss += x1[j] * x1[j] + x2[j] * x2[j];
    ss += __shfl_xor(ss, 1); ss += __shfl_xor(ss, 2); ss += __shfl_xor(ss, 4);
    const float r = rsqrtf(ss * (1.0f / 192.0f) + EPS) * scale;
#pragma unroll
    for (int j = 0; j < 16; ++j) v[j] = v[j] * r * gn[j];
    float z1[4], z2[4];
#pragma unroll
    for (int j = 0; j < 4; ++j) { const float y1 = x1[j] * r * g1[j], y2 = x2[j] * r * g2[j]; z1[j] = y1 * cs[j] - y2 * sn[j]; z2[j] = y2 * cs[j] + y1 * sn[j]; }
#pragma unroll
    for (int q = 0; q < 4; ++q) { o0[q] = pk2(v[2 * q], v[2 * q + 1]); o1[q] = pk2(v[8 + 2 * q], v[8 + 2 * q + 1]); }
#pragma unroll
    for (int q = 0; q < 2; ++q) { q1[q] = pk2(z1[2 * q], z1[2 * q + 1]); q2[q] = pk2(z2[2 * q], z2[2 * q + 1]); }
}
__device__ __forceinline__ void mla_finalize(bf16_t* Q, bf16_t* KF, const bf16_t* kpe, const int* positions, const float* gq, const float* gk, int G, int bid) {
    int tid_l = threadIdx.x; asm volatile("" : "+v"(tid_l));
    const int tid = tid_l, wave = tid >> 6, lane = tid & 63, h = lane >> 3, p = lane & 7;
    const int gw = bid * 8 + wave, NGW = G * 8;
    float gqn[16], gq1[4], gq2[4], gkn[16], gk1[4], gk2[4], invf[4];
#pragma unroll
    for (int j = 0; j < 16; ++j) { gqn[j] = gq[16 * p + j]; gkn[j] = gk[16 * p + j]; }
#pragma unroll
    for (int j = 0; j < 4; ++j) { gq1[j] = gq[128 + 4 * p + j]; gq2[j] = gq[160 + 4 * p + j]; gk1[j] = gk[128 + 4 * p + j]; gk2[j] = gk[160 + 4 * p + j];
        invf[j] = exp2f(-(float)(4 * p + j) * 0.41524101186092029f); }
    for (int row = gw; row < T; row += NGW) {
        const float pos = (float)positions[row];
        float sn[4], cs[4];
#pragma unroll
        for (int j = 0; j < 4; ++j) { const float ang = pos * invf[j]; const double rev = (double)ang * 0.15915494309189535; const float frc = (float)(rev - rint(rev));
            sn[j] = __builtin_amdgcn_sinf(frc); cs[j] = __builtin_amdgcn_cosf(frc); }
        { bf16_t* kb = KF + (size_t)row * 1536 + 192 * h; const bf16_t* kp = kpe + (size_t)row * 64;
          const u32x4 a0 = *(const u32x4*)(kb + 16 * p), a1 = *(const u32x4*)(kb + 16 * p + 8); const u32x2 r1 = *(const u32x2*)(kp + 4 * p), r2 = *(const u32x2*)(kp + 32 + 4 * p);
          u32x4 o0, o1; u32x2 q1, q2;
          fin_head(a0, a1, r1, r2, gkn, gk1, gk2, sn, cs, 1.0f, o0, o1, q1, q2);
          *(u32x4*)(kb + 16 * p) = o0; *(u32x4*)(kb + 16 * p + 8) = o1; *(u32x2*)(kb + 128 + 4 * p) = q1; *(u32x2*)(kb + 160 + 4 * p) = q2; }
    }
}

typedef __amdgpu_buffer_rsrc_t bufrsrc_t;
constexpr int AT_KP = 400, AT_VP = 144, AT_KBYTES = 64 * AT_KP, AT_STAGE = AT_KBYTES + 128 * AT_VP;
template <int MODE> __device__ __forceinline__ void attn_phase(LAS unsigned char* lds, const bf16_t* Q, const bf16_t* KF, const bf16_t* VT, bf16_t* O, const int* positions, const float* gq, int G, int bid) {
    int tid_l = threadIdx.x; asm volatile("" : "+v"(tid_l));
    const int tid = tid_l, w = tid >> 6, lane = tid & 63, lq = lane & 31, hi = lane >> 5;
    const unsigned kvo = (unsigned)((tid >> 3) * 1536 + 8 * (tid & 7));
    const unsigned vvo = (unsigned)((tid >> 3) * T + 8 * (tid & 7));
    const unsigned klo = (unsigned)((tid >> 3) * AT_KP + (tid & 7) * 16);
    const unsigned vlo = (unsigned)(AT_KBYTES + (tid >> 3) * AT_VP + ((tid & 7) >> 1) * 32 + (tid & 1) * 8);
    for (int it = bid; it < 1024; it += G) {
        const int bh = it >> 4, pp = it & 15, b = bh >> 3, h = bh & 7;
        for (int half = 0; half < 2; ++half) {
            const int j = half ? 31 - pp : pp;
            const int ntiles = 4 * j + 4, my_last = 4 * j + (w >> 1);
            const size_t qrow = (size_t)b * SEQ + 256 * j + 32 * w + lq;
            bf16x8 qf[12];
#pragma unroll
            for (int kk = 0; kk < 12; ++kk) qf[kk] = *(const bf16x8*)(Q + qrow * 1536 + 192 * h + 16 * kk + 8 * hi);
            f32x16 o[4];
#pragma unroll
            for (int db = 0; db < 4; ++db)
#pragma unroll
                for (int i = 0; i < 16; ++i) o[db][i] = 0.f;
            float mrun = 0.f, lsum = 0.f;
            const bf16_t* kg = KF + (size_t)b * SEQ * 1536 + 192 * h;
            const bf16_t* vg = VT + (size_t)(128 * h) * T + (size_t)b * SEQ;
            u32x4 kr[3], vr[2];
            const bufrsrc_t krs = __builtin_amdgcn_make_buffer_rsrc((void*)kg, 0, 0x7fffffff, 0x00020000), vrs = __builtin_amdgcn_make_buffer_rsrc((void*)vg, 0, 0x7fffffff, 0x00020000);
#define AT_GLOAD_K(kt_) do { const int so_ = ((MODE == 1) ? 0 : (kt_)) * (64 * 1536 * 2); \
                _Pragma("unroll") for (int i = 0; i < 3; ++i) kr[i] = __builtin_bit_cast(u32x4, __builtin_amdgcn_raw_buffer_load_b128(krs, (int)(kvo * 2u) + 128 * i, so_, 0)); } while (0)
#define AT_GLOAD_V(kt_) do { const int so_ = ((MODE == 1) ? 0 : (kt_)) * 128; \
                vr[0] = __builtin_bit_cast(u32x4, __builtin_amdgcn_raw_buffer_load_b128(vrs, (int)(vvo * 2u), so_, 0)); \
                vr[1] = __builtin_bit_cast(u32x4, __builtin_amdgcn_raw_buffer_load_b128(vrs, (int)(vvo * 2u), so_ + 64 * T * 2, 0)); } while (0)
#define AT_LSTORE_K(buf_) do { LAS unsigned char* nb_ = lds + (buf_) * AT_STAGE; \
                _Pragma("unroll") for (int i = 0; i < 3; ++i) *(LAS u32x4*)(nb_ + klo + 128 * i) = kr[i]; } while (0)
#define AT_LSTORE_V(buf_) do { LAS unsigned char* nb_ = lds + (buf_) * AT_STAGE; \
                *(LAS u32x2*)(nb_ + vlo) = (u32x2){vr[0].x, vr[0].y}; *(LAS u32x2*)(nb_ + vlo + 16) = (u32x2){vr[0].z, vr[0].w}; \
                *(LAS u32x2*)(nb_ + vlo + 64 * AT_VP) = (u32x2){vr[1].x, vr[1].y}; *(LAS u32x2*)(nb_ + vlo + 64 * AT_VP + 16) = (u32x2){vr[1].z, vr[1].w}; } while (0)
#define AT_LSTORE(buf_) do { AT_LSTORE_K(buf_); AT_LSTORE_V(buf_); } while (0)
            AT_GLOAD_K(0); AT_GLOAD_V(0);
            {
                float ss = 0.f;
#pragma unroll
                for (int kk = 0; kk < 12; ++kk)
#pragma unroll
                    for (int j = 0; j < 8; ++j) { const float v = bf2f((bf16_t)qf[kk][j]); ss += v * v; }
                ss += __shfl_xor(ss, 32);
                const float r = rsqrtf(ss * (1.0f / 192.0f) + EPS) * QSCALE;
#pragma unroll
                for (int kk = 0; kk < 8; ++kk) {
                    const f32x4 g0 = *(const f32x4*)(gq + 16 * kk + 8 * hi), g1 = *(const f32x4*)(gq + 16 * kk + 8 * hi + 4);
#pragma unroll
                    for (int q2 = 0; q2 < 4; ++q2) {
                        const float a = bf2f((bf16_t)qf[kk][2 * q2]) * r * ((q2 < 2) ? g0[2 * q2] : g1[2 * q2 - 4]);
                        const float c = bf2f((bf16_t)qf[kk][2 * q2 + 1]) * r * ((q2 < 2) ? g0[2 * q2 + 1] : g1[2 * q2 - 3]);
                        const unsigned pk = pk2(a, c); qf[kk][2 * q2] = (short)(pk & 0xffff); qf[kk][2 * q2 + 1] = (short)(pk >> 16);
                    }
                }
                const float pos = (float)positions[qrow];
#pragma unroll
                for (int kk = 8; kk < 10; ++kk) {
                    const f32x4 ga0 = *(const f32x4*)(gq + 16 * kk + 8 * hi), ga1 = *(const f32x4*)(gq + 16 * kk + 8 * hi + 4);
                    const f32x4 gb0 = *(const f32x4*)(gq + 16 * kk + 32 + 8 * hi), gb1 = *(const f32x4*)(gq + 16 * kk + 32 + 8 * hi + 4);
                    float z1[8], z2[8];
#pragma unroll
                    for (int j = 0; j < 8; ++j) {
                        const int i = 16 * (kk - 8) + 8 * hi + j;
                        const float ang = pos * exp2f(-(float)i * 0.41524101186092029f);
                        const double rev = (double)ang * 0.15915494309189535; const float frc = (float)(rev - rint(rev));
                        const float sn = __builtin_amdgcn_sinf(frc), cs = __builtin_amdgcn_cosf(frc);
                        const float y1 = bf2f((bf16_t)qf[kk][j]) * r * ((j < 4) ? ga0[j] : ga1[j - 4]);
                        const float y2 = bf2f((bf16_t)qf[kk + 2][j]) * r * ((j < 4) ? gb0[j] : gb1[j - 4]);
                        z1[j] = y1 * cs - y2 * sn; z2[j] = y2 * cs + y1 * sn;
                    }
#pragma unroll
                    for (int q2 = 0; q2 < 4; ++q2) {
                        const unsigned p1 = pk2(z1[2 * q2], z1[2 * q2 + 1]), p2 = pk2(z2[2 * q2], z2[2 * q2 + 1]);
                        qf[kk][2 * q2] = (short)(p1 & 0xffff); qf[kk][2 * q2 + 1] = (short)(p1 >> 16);
                        qf[kk + 2][2 * q2] = (short)(p2 & 0xffff); qf[kk + 2][2 * q2 + 1] = (short)(p2 >> 16);
                    }
                }
            }
            AT_LSTORE(0);
            __syncthreads();
            for (int kt = 0; kt < ntiles; ++kt) {
                const bool more = (kt + 1 < ntiles);
                if (more && MODE < 3) { AT_GLOAD_K(kt + 1); AT_GLOAD_V(kt + 1); }
                if (kt <= my_last) {
                    LAS unsigned char* kb = lds + (kt & 1) * AT_STAGE; LAS unsigned char* vb = kb + AT_KBYTES;
#define AT_RESCALE(EXTRA) do { const float d_ = fmaxf(mx, 0.f), alpha_ = __builtin_amdgcn_exp2f(-d_); mrun += d_; lsum *= alpha_; \
                        _Pragma("unroll") for (int db = 0; db < 4; ++db) _Pragma("unroll") for (int i = 0; i < 16; ++i) o[db][i] *= alpha_; EXTRA } while (0)
                    f32x16 s0, s1;
#pragma unroll
                    for (int i = 0; i < 16; ++i) s0[i] = -mrun;
                    bf16x8 fr[8], fr2[4];
#pragma unroll
                    for (int kk = 0; kk < 8; ++kk) fr[kk] = *(const LAS bf16x8*)(kb + lq * AT_KP + (16 * kk + 8 * hi) * 2);
                    __builtin_amdgcn_sched_barrier(0);
#pragma unroll
                    for (int kk = 0; kk < 4; ++kk) s0 = __builtin_amdgcn_mfma_f32_32x32x16_bf16(fr[kk], qf[kk], s0, 0, 0, 0);
                    __builtin_amdgcn_sched_barrier(0);
#pragma unroll
                    for (int kk = 8; kk < 12; ++kk) fr2[kk - 8] = *(const LAS bf16x8*)(kb + lq * AT_KP + (16 * kk + 8 * hi) * 2);
                    __builtin_amdgcn_sched_barrier(0);
#pragma unroll
                    for (int kk = 4; kk < 8; ++kk) s0 = __builtin_amdgcn_mfma_f32_32x32x16_bf16(fr[kk], qf[kk], s0, 0, 0, 0);
#pragma unroll
                    for (int kk = 8; kk < 12; ++kk) s0 = __builtin_amdgcn_mfma_f32_32x32x16_bf16(fr2[kk - 8], qf[kk], s0, 0, 0, 0);
                    __builtin_amdgcn_sched_barrier(0);
#pragma unroll
                    for (int kk = 0; kk < 8; ++kk) fr[kk] = *(const LAS bf16x8*)(kb + (32 + lq) * AT_KP + (16 * kk + 8 * hi) * 2);
                    __builtin_amdgcn_sched_barrier(0);
                    float mx = fmaxf(fmaxf(s0[0], s0[1]), fmaxf(s0[2], s0[3]));
#pragma unroll
                    for (int i = 4; i < 16; i += 2) mx = fmaxf(mx, fmaxf(s0[i], s0[i + 1]));
                    mx = fmaxf(mx, __shfl_xor(mx, 32));
                    if (__any(mx > 6.0f)) AT_RESCALE(_Pragma("unroll") for (int i = 0; i < 16; ++i) s0[i] -= d_;);
#pragma unroll
                    for (int i = 0; i < 16; ++i) s1[i] = -mrun;
                    __builtin_amdgcn_sched_barrier(0);
                    float ps = 0.f;
#pragma unroll
                    for (int kk = 0; kk < 4; ++kk) s1 = __builtin_amdgcn_mfma_f32_32x32x16_bf16(fr[kk], qf[kk], s1, 0, 0, 0);
#pragma unroll
                    for (int i = 0; i < 5; ++i) { s0[i] = __builtin_amdgcn_exp2f(s0[i]); ps += s0[i]; }
#pragma unroll
                    for (int g = 0; g < 4; ++g) { __builtin_amdgcn_sched_group_barrier(0x008, 1, 0); __builtin_amdgcn_sched_group_barrier(0x002, 3, 0); }
                    __builtin_amdgcn_sched_barrier(0);
#pragma unroll
                    for (int kk = 8; kk < 12; ++kk) fr2[kk - 8] = *(const LAS bf16x8*)(kb + (32 + lq) * AT_KP + (16 * kk + 8 * hi) * 2);
                    __builtin_amdgcn_sched_barrier(0);
#pragma unroll
                    for (int kk = 4; kk < 8; ++kk) s1 = __builtin_amdgcn_mfma_f32_32x32x16_bf16(fr[kk], qf[kk], s1, 0, 0, 0);
#pragma unroll
                    for (int kk = 8; kk < 12; ++kk) s1 = __builtin_amdgcn_mfma_f32_32x32x16_bf16(fr2[kk - 8], qf[kk], s1, 0, 0, 0);
#pragma unroll
                    for (int i = 5; i < 16; ++i) { s0[i] = __builtin_amdgcn_exp2f(s0[i]); ps += s0[i]; }
#pragma unroll
                    for (int g = 0; g < 8; ++g) { __builtin_amdgcn_sched_group_barrier(0x008, 1, 0); __builtin_amdgcn_sched_group_barrier(0x002, 3, 0); }
                    __builtin_amdgcn_sched_barrier(0);
                    bf16x8 va[8];
#pragma unroll
                    for (int ks = 0; ks < 2; ++ks)
#pragma unroll
                        for (int db = 0; db < 4; ++db) va[ks * 4 + db] = *(const LAS bf16x8*)(vb + (32 * db + lq) * AT_VP + (16 * ks + 8 * hi) * 2);
                    __builtin_amdgcn_sched_barrier(0);
                    mx = fmaxf(fmaxf(s1[0], s1[1]), fmaxf(s1[2], s1[3]));
#pragma unroll
                    for (int i = 4; i < 16; i += 2) mx = fmaxf(mx, fmaxf(s1[i], s1[i + 1]));
                    mx = fmaxf(mx, __shfl_xor(mx, 32));
                    if (__any(mx > 6.0f)) AT_RESCALE(ps *= alpha_; _Pragma("unroll") for (int i = 0; i < 16; ++i) { s0[i] *= alpha_; s1[i] -= d_; });
                    lsum += ps;
                    bf16x8 pb[2];
#pragma unroll
                    for (int ks = 0; ks < 2; ++ks)
#pragma unroll
                        for (int q = 0; q < 4; ++q) { const unsigned pk = pk2(s0[8 * ks + 2 * q], s0[8 * ks + 2 * q + 1]); pb[ks][2 * q] = (short)(pk & 0xffff); pb[ks][2 * q + 1] = (short)(pk >> 16); }
                    __builtin_amdgcn_sched_barrier(0);
#pragma unroll
                    for (int ks = 0; ks < 2; ++ks)
#pragma unroll
                        for (int db = 0; db < 4; ++db) o[db] = __builtin_amdgcn_mfma_f32_32x32x16_bf16(va[ks * 4 + db], pb[ks], o[db], 0, 0, 0);
                    float ps1 = 0.f;
#pragma unroll
                    for (int i = 0; i < 16; ++i) { s1[i] = __builtin_amdgcn_exp2f(s1[i]); ps1 += s1[i]; }
#pragma unroll
                    for (int g = 0; g < 8; ++g) { __builtin_amdgcn_sched_group_barrier(0x008, 1, 0); __builtin_amdgcn_sched_group_barrier(0x002, 4, 0); }
                    __builtin_amdgcn_sched_barrier(0);
                    lsum += ps1;
#pragma unroll
                    for (int ks = 0; ks < 2; ++ks)
#pragma unroll
                        for (int db = 0; db < 4; ++db) va[ks * 4 + db] = *(const LAS bf16x8*)(vb + (32 * db + lq) * AT_VP + (16 * (ks + 2) + 8 * hi) * 2);
                    if (more && MODE < 3) AT_LSTORE((kt + 1) & 1);
                    __builtin_amdgcn_sched_barrier(0);
#pragma unroll
                    for (int ks = 0; ks < 2; ++ks)
#pragma unroll
                        for (int q = 0; q < 4; ++q) { const unsigned pk = pk2(s1[8 * ks + 2 * q], s1[8 * ks + 2 * q + 1]); pb[ks][2 * q] = (short)(pk & 0xffff); pb[ks][2 * q + 1] = (short)(pk >> 16); }
                    __builtin_amdgcn_sched_barrier(0);
#pragma unroll
                    for (int ks = 0; ks < 2; ++ks)
#pragma unroll
                        for (int db = 0; db < 4; ++db) o[db] = __builtin_amdgcn_mfma_f32_32x32x16_bf16(va[ks * 4 + db], pb[ks], o[db], 0, 0, 0);
#undef AT_RESCALE
                }
                if (more && MODE < 3 && kt > my_last) AT_LSTORE((kt + 1) & 1);
                if (MODE != 4) __syncthreads();
            }
#undef AT_GLOAD_K
#undef AT_GLOAD_V
#undef AT_LSTORE
#undef AT_LSTORE_K
#undef AT_LSTORE_V
            lsum += __shfl_xor(lsum, 32);
            const float inv = 1.0f / lsum;
            int t2 = threadIdx.x; asm volatile("" : "+v"(t2));
            const size_t qrow2 = (size_t)b * SEQ + 256 * j + 32 * (t2 >> 6) + (t2 & 31);
            bf16_t* op = O + qrow2 * 2048 + 128 * h;
#pragma unroll
            for (int db = 0; db < 4; ++db)
#pragma unroll
                for (int g4 = 0; g4 < 4; ++g4) {
                    u32x2 wv; wv.x = pk2(o[db][4 * g4] * inv, o[db][4 * g4 + 1] * inv); wv.y = pk2(o[db][4 * g4 + 2] * inv, o[db][4 * g4 + 3] * inv);
                    *(u32x2*)(op + 32 * db + 8 * g4 + 4 * hi) = wv;
                }
        }
    }
}

#ifndef PH_MASK
#define PH_MASK 0xFFFFF
#endif
__global__ void __launch_bounds__(512, 2) fwd_megakernel(Params p) {
    extern __shared__ __attribute__((aligned(16))) unsigned char lds_raw[];
    LAS unsigned char* lds = (LAS unsigned char*)lds_raw;
    cg::grid_group grid = cg::this_grid();
    const int G = gridDim.x, bid = blockIdx.x;
#define FRESH_LANE_IDS int tid_l = threadIdx.x; asm volatile("" : "+v"(tid_l)); const int wave = tid_l >> 6, lane = tid_l & 63, gw = bid * 8 + wave, NGW = G * 8
#define WSB karg_ws()
#define OUTP karg_out()
#define ssq_mix ((float*)(WSB + WS_SSQ_MIX))
#define ssq_cq ((float*)(WSB + WS_SSQ_CQ))
#define ssq_ckv ((float*)(WSB + WS_SSQ_CKV))
#define ssq2 ((float*)(WSB + WS_SSQ2))
#define R3 ((bf16_t*)(WSB + WS_R3))
#define IG ((bf16_t*)(WSB + WS_IG))
#define QF ((bf16_t*)(WSB + WS_QF))
#define HID ((bf16_t*)(WSB + WS_HID))
#define KF ((bf16_t*)(WSB + WS_KF))
#define cqg ((bf16_t*)(WSB + WS_CQG))
#define ckvg ((bf16_t*)(WSB + WS_CKVG))
#define kpe ((bf16_t*)(WSB + WS_KPE))
#define HB ((bf16_t*)OUTP)
#define HGM (((bf16_t*)OUTP) + (size_t)T * DM)
#define H3 ((bf16_t*)(WSB + 544 * MiB))

    if constexpr (PH_MASK & 1) prologue(lds, G, bid);
    grid.sync();
    if constexpr (PH_MASK & 2) { EpiSwiglu E{HID, nullptr}; run_gemm(lds, R3, (const bf16_t*)(WSB + WS_W1IN), T, 5632, 1024, E, G, bid); }
    grid.sync();
    if constexpr (PH_MASK & 4) { EpiRes<float, bf16_t, 1> E{karg_in(0), HB, HGM, karg_in(5), ssq_mix}; run_gemm(lds, HID, (const bf16_t*)(WSB + WS_W1OUT), T, 1024, DFF, E, G, bid); }
    grid.sync();
    if constexpr (PH_MASK & 8) { EpiIn E{QF, IG, cqg, ckvg, kpe, ssq_mix, ssq_cq, ssq_ckv, karg_in(10), karg_in(12)}; run_gemm(lds, HGM, (const bf16_t*)(WSB + WS_WIN), T, NIN, 1024, E, G, bid); }
    grid.sync();
    if constexpr (PH_MASK & 16) {
        FRESH_LANE_IDS;
        for (int m = gw; m < T; m += NGW) {
            const float rq = rsqrtf(ssq_cq[m] * (1.0f / 384.0f) + EPS), rk = rsqrtf(ssq_ckv[m] * (1.0f / 256.0f) + EPS);
            if (lane < 48) { u32x4* pq = (u32x4*)(cqg + (size_t)m * 384) + lane; u32x4 v = *pq;
#pragma unroll
                for (int q = 0; q < 4; ++q) v[q] = pk2(__uint_as_float(v[q] << 16) * rq, __uint_as_float(v[q] & 0xffff0000u) * rq);
                *pq = v; }
            if (lane < 32) { u32x4* pk = (u32x4*)(ckvg + (size_t)m * 256) + lane; u32x4 v = *pk;
#pragma unroll
                for (int q = 0; q < 4; ++q) v[q] = pk2(__uint_as_float(v[q] << 16) * rk, __uint_as_float(v[q] & 0xffff0000u) * rk);
                *pk = v; }
        }
    }
    if constexpr (PH_MASK & 16) hg_prepass(lds, QF, karg_in(7), (bf16_t*)(WSB + WS_P), (float*)(WSB + WS_ER), G, bid);
    grid.sync();
    if constexpr (PH_MASK & 32) hg_recur(lds, QF, IG, (const bf16_t*)(WSB + WS_P), (const float*)(WSB + WS_ER), (float*)(WSB + WS_SSQO), G, bid);
    grid.sync();
    if constexpr (PH_MASK & 32) hg_norm_pass(IG, (const float*)(WSB + WS_SSQO), karg_in(8), G, bid);
    if constexpr (PH_MASK & 64) { EpiPlain<1536, 128> E{QF}; run_gemm(lds, cqg, (const bf16_t*)(WSB + WS_WQ), T, 1536, 384, E, G, bid); }
    if constexpr (PH_MASK & 64) { EpiPlain<1536, 192> E{KF}; run_gemm(lds, ckvg, (const bf16_t*)(WSB + WS_WKV), T, 1024, 256, E, G, bid); }
    if constexpr (PH_MASK & 128) { EpiPlain<T, 128> E{R3}; run_gemm(lds, (const bf16_t*)(WSB + WS_WKV) + (size_t)1024 * 256, ckvg, 1024, T, 256, E, G, bid); }
    grid.sync();
    if constexpr (PH_MASK & 256) mla_finalize(QF, KF, kpe, (const int*)karg_in(1), karg_in(14), karg_in(15), G, bid);
    grid.sync();
    if constexpr (PH_MASK & 512) attn_phase<0>(lds, QF, KF, R3, IG, (const int*)karg_in(1), karg_in(14), G, bid);
    grid.sync();
    if constexpr (PH_MASK & 1024) { EpiGate E{QF, ssq_mix, karg_in(18)}; run_gemm(lds, HGM, (const bf16_t*)(WSB + WS_WMG), T, 2048, 1024, E, G, bid); }
    grid.sync();
    if constexpr (PH_MASK & 2048) { EpiBranch<false> E{QF, 1024, cqg, nullptr}; run_gemm(lds, IG, (const bf16_t*)(WSB + WS_WBR), T, 1024, 1024, E, G, bid, 2048, 2048); }
    if constexpr (PH_MASK & 2048) { EpiBranch<true> E{QF, 0, cqg, R3}; run_gemm(lds, IG + 1024, (const bf16_t*)(WSB + WS_WBR) + 1024, T, 1024, 1024, E, G, bid, 2048, 2048); }
    grid.sync();
    if constexpr (PH_MASK & 4096) { EpiRes<bf16_t, bf16_t, 2> E{HB, HB, KF, karg_in(20), ssq2}; run_gemm(lds, R3, (const bf16_t*)(WSB + WS_WOUT), T, 1024, 1024, E, G, bid); }
    grid.sync();
    if constexpr (PH_MASK & 8192) { EpiSwiglu E{HID, ssq2}; run_gemm(lds, KF, (const bf16_t*)(WSB + WS_W2IN), T, 5632, 1024, E, G, bid); }
    grid.sync();
    if constexpr (PH_MASK & 16384) { EpiRes<bf16_t, bf16_t, 1> E{HB, H3, nullptr, nullptr, nullptr}; run_gemm(lds, HID, (const bf16_t*)(WSB + WS_W2OUT), T, 1024, DFF, E, G, bid); }
    grid.sync();
    { FRESH_LANE_IDS;
    for (int m = gw; m < T; m += NGW) {
        const u32x2* xr = (const u32x2*)(H3 + (size_t)m * DM) + lane; f32x4* orow = (f32x4*)(OUTP + (size_t)m * DM) + lane; const f32x4* gr = (const f32x4*)karg_in(23) + lane;
        f32x4 v[4]; float s = 0.f;
#pragma unroll
        for (int j = 0; j < 4; ++j) { const u32x2 a = xr[64 * j];
            v[j] = (f32x4){__uint_as_float(a.x << 16), __uint_as_float(a.x & 0xffff0000u), __uint_as_float(a.y << 16), __uint_as_float(a.y & 0xffff0000u)};
            s += (v[j].x * v[j].x + v[j].y * v[j].y) + (v[j].z * v[j].z + v[j].w * v[j].w); }
        const float r = rsqrtf(wave_sum(s) * (1.0f / DM) + EPS);
#pragma unroll
        for (int j = 0; j < 4; ++j) orow[64 * j] = v[j] * r * gr[64 * j];
    } }
#if defined(PROBE_PHASE)
    grid.sync();
#if PROBE_PHASE == 1
    attn_phase<0>(lds, QF, KF, R3, IG, (const int*)karg_in(1), karg_in(14), G, bid);
#elif PROBE_PHASE == 10
    attn_phase<1>(lds, QF, KF, R3, IG, (const int*)karg_in(1), karg_in(14), G, bid);
#elif PROBE_PHASE == 12
    attn_phase<2>(lds, QF, KF, R3, IG, (const int*)karg_in(1), karg_in(14), G, bid);
#elif PROBE_PHASE == 13
    attn_phase<3>(lds, QF, KF, R3, IG, (const int*)karg_in(1), karg_in(14), G, bid);
#elif PROBE_PHASE == 14
    attn_phase<4>(lds, QF, KF, R3, IG, (const int*)karg_in(1), karg_in(14), G, bid);
#elif PROBE_PHASE == 2
    hg_recur(lds, QF, IG, (const bf16_t*)(WSB + WS_P), (const float*)(WSB + WS_ER), (float*)(WSB + WS_SSQO), G, bid);
#elif PROBE_PHASE == 3
    hg_prepass(lds, QF, karg_in(7), (bf16_t*)(WSB + WS_P), (float*)(WSB + WS_ER), G, bid);
#elif PROBE_PHASE == 4
    prologue(lds, G, bid);
#elif PROBE_PHASE == 6
    { EpiSwiglu E{HID, ssq2}; run_gemm(lds, KF, (const bf16_t*)(WSB + WS_W2IN), T, 5632, 1024, E, G, bid); }
#elif PROBE_PHASE == 7
    { EpiRes<bf16_t, float, 1> E{HB, (float*)(WSB + 600 * MiB), nullptr, nullptr, nullptr}; run_gemm(lds, HID, (const bf16_t*)(WSB + WS_W2OUT), T, 1024, DFF, E, G, bid); }
#elif PROBE_PHASE == 8
    { EpiIn E{QF, IG, cqg, ckvg, kpe, ssq_mix, ssq_cq, ssq_ckv, karg_in(10), karg_in(12)}; run_gemm(lds, R3, (const bf16_t*)(WSB + WS_WIN), T, NIN, 1024, E, G, bid); }
#elif PROBE_PHASE == 9
    { EpiGate E{QF, ssq_mix, karg_in(18)}; run_gemm(lds, R3, (const bf16_t*)(WSB + WS_WMG), T, 2048, 1024, E, G, bid); }
#elif PROBE_PHASE == 11
    { EpiPlain<1536, 128> E{QF}; run_gemm(lds, cqg, (const bf16_t*)(WSB + WS_WQ), T, 1536, 384, E, G, bid); }
    { EpiPlain<1536, 192> E{KF}; run_gemm(lds, ckvg, (const bf16_t*)(WSB + WS_WKV), T, 1024, 256, E, G, bid); }
    { EpiPlain<T, 128> E{R3}; run_gemm(lds, (const bf16_t*)(WSB + WS_WKV) + (size_t)1024 * 256, ckvg, 1024, T, 256, E, G, bid); }
#elif PROBE_PHASE == 5
    mla_finalize(QF, KF, kpe, (const int*)karg_in(1), karg_in(14), karg_in(15), G, bid);
#endif
#endif
}

extern "C" void kernel_launch(void* const* d_in, const int* in_sizes, int n_in, void* d_out, int out_size, void* d_ws, size_t ws_size, hipStream_t stream) {
    static int grid_blocks = 0;
    if (grid_blocks == 0) {
        if (n_in != 24 || out_size != T * DM || ws_size < WS_NEED) { fprintf(stderr, "kernel_launch: unexpected shapes (n_in %d out %d ws %zu)\n", n_in, out_size, ws_size); grid_blocks = -1; return; }
        int dev = 0, cus = 0, per_cu = 0;
        hipGetDevice(&dev);
        hipDeviceGetAttribute(&cus, hipDeviceAttributeMultiprocessorCount, dev);
        if (hipFuncSetAttribute((const void*)fwd_megakernel, hipFuncAttributeMaxDynamicSharedMemorySize, LDS_BYTES) != hipSuccess) { fprintf(stderr, "kernel_launch: hipFuncSetAttribute failed\n"); grid_blocks = -1; return; }
        if (hipOccupancyMaxActiveBlocksPerMultiprocessor(&per_cu, (const void*)fwd_megakernel, 512, LDS_BYTES) != hipSuccess || per_cu < 1) { fprintf(stderr, "kernel_launch: occupancy query gave %d\n", per_cu); per_cu = 1; (void)hipGetLastError(); }
        grid_blocks = cus * per_cu;
    }
    if (grid_blocks < 0) return;
    Params p{};
    for (int i = 0; i < 24; ++i) p.in[i] = (const float*)d_in[i];
    p.out = (float*)d_out; p.ws = (unsigned char*)d_ws;
    void* args[] = {&p};
    hipError_t e = hipLaunchCooperativeKernel((const void*)fwd_megakernel, dim3(grid_blocks), dim3(512), args, LDS_BYTES, stream);
    if (e != hipSuccess) fprintf(stderr, "cooperative launch failed: %s (grid %d)\n", hipGetErrorString(e), grid_blocks);
}
```
